# Optimizing an MI355X kernel written in HIP

```python
import math
import jax, jax.numpy as jnp
from jax import lax
import numpy as np

D_MODEL = 1024
BATCH = 8
SEQ = 4096
DEPTH = 4

GRID_W = 64
CTX_LEN = 256
N_MIXERS = 2
N_NA_LAYERS = (DEPTH + N_MIXERS - 1) // N_MIXERS
N_HY_LAYERS = DEPTH // N_MIXERS
N_HEADS = 16
HEAD_DIM = D_MODEL // N_HEADS
KH_MAX = 8
KW = 16
Q_BLOCK_W = 16
K_BLOCK_W = Q_BLOCK_W + KW
N_COL_BLOCKS = GRID_W // Q_BLOCK_W
HY_ORDER = 2
HY_EMB_DIM = 33
HY_FILTER_ORDER = 64
HY_N_SIN = 3
HY_FAST_DECAY = 0.3
HY_SLOW_DECAY = 1.5
HY_TARGET = 1e-2
LN_EPS = 1e-5
ALPHA = (2 * DEPTH) ** 0.25
BETA = (8 * DEPTH) ** -0.25
NEG_INF = -1e30

kernel_name = "hybrid_na_hyena_deepnorm_prefix"


def layer_norm(x, g, b):
    xf = x.astype(jnp.float32)
    mu = xf.mean(-1, keepdims=True)
    var = jnp.square(xf - mu).mean(-1, keepdims=True)
    return ((xf - mu) * lax.rsqrt(var + LN_EPS)).astype(x.dtype) * g + b


def _col_block_layout():
    q_cols = np.arange(GRID_W).reshape(N_COL_BLOCKS, Q_BLOCK_W)
    q_start = np.clip(q_cols - KW // 2, 0, GRID_W - KW)
    blk_start = np.clip(np.arange(N_COL_BLOCKS) * Q_BLOCK_W - KW // 2, 0, GRID_W - K_BLOCK_W)
    k_cols = blk_start[:, None] + np.arange(K_BLOCK_W)
    kc = k_cols[:, None, :]
    in_win = (kc >= q_start[:, :, None]) & (kc < q_start[:, :, None] + KW)
    dcol = np.clip(kc - q_cols[:, :, None] + KW - 1, 0, 2 * KW - 2)
    return k_cols, in_win, dcol


def neighbourhood_attention(q, k, v, k_ctx, v_ctx, rpb):
    B, S, H, Dh = q.shape
    rows = S // GRID_W
    kh = min(KH_MAX, rows)
    k_cols, in_win, dcol = _col_block_layout()
    k_grid = k.reshape(B, rows, GRID_W, H, Dh)
    v_grid = v.reshape(B, rows, GRID_W, H, Dh)
    q_rows = jnp.moveaxis(q.reshape(B, rows, N_COL_BLOCKS, Q_BLOCK_W, H, Dh), 1, 0) * (Dh ** -0.5)
    mask = jnp.asarray(in_win)[None, None, :, :, None, :]
    n_lat = kh * K_BLOCK_W

    def one_row(args):
        r, q_r = args
        r0 = jnp.clip(r - kh // 2, 0, rows - kh)
        k_r = lax.dynamic_slice_in_dim(k_grid, r0, kh, axis=1)[:, :, k_cols]
        v_r = lax.dynamic_slice_in_dim(v_grid, r0, kh, axis=1)[:, :, k_cols]
        drow = r0 + jnp.arange(kh) - r + KH_MAX - 1
        bias = jnp.take(rpb, drow, axis=1)[:, :, dcol]
        bias = jnp.transpose(bias, (0, 2, 3, 1, 4)).astype(jnp.float32)
        s_lat = jnp.einsum('bnqhd,binjhd->bhnqij', q_r, k_r).astype(jnp.float32) + bias[None]
        s_lat = jnp.where(mask, s_lat, NEG_INF).reshape(B, H, N_COL_BLOCKS, Q_BLOCK_W, n_lat)
        s_ctx = jnp.einsum('bnqhd,bchd->bhnqc', q_r, k_ctx).astype(jnp.float32)
        p = jax.nn.softmax(jnp.concatenate([s_lat, s_ctx], axis=-1), axis=-1).astype(v.dtype)
        p_lat = p[..., :n_lat].reshape(B, H, N_COL_BLOCKS, Q_BLOCK_W, kh, K_BLOCK_W)
        p_ctx = p[..., n_lat:]
        o = (jnp.einsum('bhnqij,binjhd->bnqhd', p_lat, v_r)
             + jnp.einsum('bhnqc,bchd->bnqhd', p_ctx, v_ctx))
        return o.reshape(B, GRID_W, H, Dh)

    out = lax.map(one_row, (jnp.arange(rows), q_rows))
    return jnp.moveaxis(out, 0, 1).reshape(B, S, H, Dh)


def dense_attention(q, k, v):
    s = jnp.einsum('bqhd,bkhd->bhqk', q * (q.shape[-1] ** -0.5), k).astype(jnp.float32)
    p = jax.nn.softmax(s, axis=-1).astype(v.dtype)
    return jnp.einsum('bhqk,bkhd->bqhd', p, v)


def _heads(t):
    return t.reshape(t.shape[0], t.shape[1], N_HEADS, HEAD_DIM)


def na_mixer(h, hc, w_in, w_out, rpb, with_ctx_out):
    B, S, D = h.shape
    q, k, v, z = jnp.split(h @ w_in, 4, axis=-1)
    if with_ctx_out:
        qc, kc, vc, zc = jnp.split(hc @ w_in, 4, axis=-1)
    else:
        kc, vc = jnp.split(hc @ w_in[:, D:3 * D], 2, axis=-1)
    o = neighbourhood_attention(_heads(q), _heads(k), _heads(v), _heads(kc), _heads(vc), rpb).reshape(B, S, D)
    y = (o * jax.nn.silu(z)) @ w_out
    if not with_ctx_out:
        return y, None
    oc = dense_attention(_heads(qc), _heads(kc), _heads(vc)).reshape(hc.shape)
    yc = (oc * jax.nn.silu(zc)) @ w_out
    return y, yc


def short_conv(u, w, b):
    up = jnp.pad(u, ((0, 0), (1, 1), (0, 0)))
    return up[:, :-2] * w[0] + up[:, 1:-1] * w[1] + up[:, 2:] * w[2] + b


def hyena_filters(L, w1, b1, w2, b2, w3, b3, w4, freq):
    t = jnp.linspace(0.0, 1.0, L, dtype=jnp.float32)[:, None]
    bands = (HY_EMB_DIM - 1) // 2
    wpos = 2.0 * math.pi * jnp.arange(L, dtype=jnp.float32)[:, None] / L
    f = jnp.linspace(1e-4, bands - 1, bands, dtype=jnp.float32)[None, :]
    z = jnp.concatenate([t, jnp.cos(f * wpos), -jnp.sin(f * wpos)], axis=-1)
    a = jnp.sin(freq[0] * (z @ w1 + b1))
    a = jnp.sin(freq[1] * (a @ w2 + b2))
    a = jnp.sin(freq[2] * (a @ w3 + b3))
    width = w4.shape[-1] // (2 * HY_ORDER)
    hf = (a @ w4).astype(jnp.float32).reshape(L, HY_ORDER, 2, width)
    max_decay = math.log(HY_TARGET) / HY_FAST_DECAY
    min_decay = math.log(HY_TARGET) / HY_SLOW_DECAY
    deltas = jnp.abs(jnp.linspace(min_decay, max_decay, width, dtype=jnp.float32))
    hf = hf * jnp.exp(-t[:, :, None, None] * deltas)
    fwd = hf[:, :, 0]
    bwd = hf[1:, :, 1][::-1]
    taps = jnp.concatenate([fwd, jnp.zeros((1,) + fwd.shape[1:], jnp.float32), bwd], axis=0)
    taps = taps / jnp.sum(jnp.abs(taps), axis=0, keepdims=True)
    return jnp.fft.rfft(taps, n=2 * L, axis=0)


def long_conv(u, h_fft, skip):
    L = u.shape[1]
    uf = jnp.fft.rfft(u.astype(jnp.float32), n=2 * L, axis=1)
    y = jnp.fft.irfft(uf * h_fft[None], n=2 * L, axis=1)[:, :L]
    return (y + u.astype(jnp.float32) * skip).astype(u.dtype)


def hyena_mixer(h, w_in, w_out, conv_w, conv_b, filt, skip):
    L = h.shape[1]
    proj = h @ w_in
    width = proj.shape[-1] // 4
    pre, g = proj[..., :3 * width], proj[..., 3 * width:]
    v, x1, x2 = jnp.split(short_conv(pre, conv_w, conv_b), 3, axis=-1)
    h_fft = hyena_filters(L, *filt)
    z = x1 * long_conv(v, h_fft[:, 0], skip[0])
    z = x2 * long_conv(z, h_fft[:, 1], skip[1])
    return (z * jax.nn.silu(g)) @ w_out


def setup_inputs(seed: int = 0) -> dict:
    key = jax.random.key(seed)
    ks = jax.random.split(key, 22)
    D = D_MODEL
    f32 = jnp.float32

    def nrm(k, shape, s):
        return jax.random.normal(k, shape, f32) * s

    return {
        "x": nrm(ks[0], (BATCH, SEQ, D), 1.0),
        "c": nrm(ks[1], (BATCH, D), 1.0),
        "ctx": nrm(ks[2], (BATCH, CTX_LEN, D), 1.0),
        "c_ctx": nrm(ks[3], (D,), 1.0),
        "w_ada": nrm(ks[4], (DEPTH, D, 3 * D), 0.5 * D ** -0.5),
        "b_ada": nrm(ks[5], (DEPTH, 3 * D), 0.02),
        "w_in": nrm(ks[6], (DEPTH, D, 4 * D), D ** -0.5),
        "w_out": nrm(ks[7], (DEPTH, D, D), BETA * D ** -0.5),
        "ln_g": 1.0 + nrm(ks[8], (DEPTH, D), 0.05),
        "ln_b": nrm(ks[9], (DEPTH, D), 0.02),
        "na_rpb": nrm(ks[10], (N_NA_LAYERS, N_HEADS, 2 * KH_MAX - 1, 2 * KW - 1), 0.1),
        "hy_conv_w": nrm(ks[11], (N_HY_LAYERS, 3, 3 * D), 3 ** -0.5),
        "hy_conv_b": nrm(ks[12], (N_HY_LAYERS, 3 * D), 0.02),
        "hy_f_w1": nrm(ks[13], (N_HY_LAYERS, HY_EMB_DIM, HY_FILTER_ORDER), HY_EMB_DIM ** -0.5),
        "hy_f_b1": nrm(ks[14], (N_HY_LAYERS, HY_FILTER_ORDER), 0.1),
        "hy_f_w2": nrm(ks[15], (N_HY_LAYERS, HY_FILTER_ORDER, HY_FILTER_ORDER), HY_FILTER_ORDER ** -0.5),
        "hy_f_b2": nrm(ks[16], (N_HY_LAYERS, HY_FILTER_ORDER), 0.1),
        "hy_f_w3": nrm(ks[17], (N_HY_LAYERS, HY_FILTER_ORDER, HY_FILTER_ORDER), HY_FILTER_ORDER ** -0.5),
        "hy_f_b3": nrm(ks[18], (N_HY_LAYERS, HY_FILTER_ORDER), 0.1),
        "hy_f_w4": nrm(ks[19], (N_HY_LAYERS, HY_FILTER_ORDER, 2 * HY_ORDER * D), HY_FILTER_ORDER ** -0.5),
        "hy_f_freq": 1.0 + nrm(ks[20], (N_HY_LAYERS, HY_N_SIN, HY_FILTER_ORDER), 0.05),
        "hy_skip": nrm(ks[21], (N_HY_LAYERS, HY_ORDER, D), 0.5),
    }


def reference(x, c, ctx, c_ctx, w_ada, b_ada, w_in, w_out, ln_g, ln_b, na_rpb, hy_conv_w, hy_conv_b,
              hy_f_w1, hy_f_b1, hy_f_w2, hy_f_b2, hy_f_w3, hy_f_b3, hy_f_w4, hy_f_freq, hy_skip):
    sc = jax.nn.silu(c)
    sc_ctx = jax.nn.silu(c_ctx)
    for i in range(DEPTH):
        last = i == DEPTH - 1
        j = i // N_MIXERS
        shift, scale, gate = jnp.split((sc @ w_ada[i] + b_ada[i])[:, None, :], 3, axis=-1)
        shift_c, scale_c, gate_c = jnp.split(sc_ctx @ w_ada[i] + b_ada[i], 3, axis=-1)
        h = x * (1 + scale) + shift
        hc = ctx * (1 + scale_c) + shift_c
        if i % N_MIXERS == 0:
            y, yc = na_mixer(h, hc, w_in[i], w_out[i], na_rpb[j], not last)
        else:
            filt = (hy_f_w1[j], hy_f_b1[j], hy_f_w2[j], hy_f_b2[j], hy_f_w3[j], hy_f_b3[j],
                    hy_f_w4[j], hy_f_freq[j])
            y = hyena_mixer(h, w_in[i], w_out[i], hy_conv_w[j], hy_conv_b[j], filt, hy_skip[j])
            yc = None if last else hyena_mixer(hc, w_in[i], w_out[i], hy_conv_w[j], hy_conv_b[j], filt, hy_skip[j])
        x = layer_norm(ALPHA * x + gate * y, ln_g[i], ln_b[i])
        if not last:
            ctx = layer_norm(ALPHA * ctx + gate_c * yc, ln_g[i], ln_b[i])
    return x
```

```cpp
#include <hip/hip_runtime.h>
#include <hip/hip_cooperative_groups.h>
#include <hip/hip_fp16.h>
#include <cstdio>
namespace cg = cooperative_groups;

#ifndef SINGLE_LAUNCH
#define SINGLE_LAUNCH 1
#endif

#define LAS __attribute__((address_space(3)))
typedef unsigned short bf16_t;
typedef short bf16x8 __attribute__((ext_vector_type(8)));
typedef short bf16x4 __attribute__((ext_vector_type(4)));
typedef float f32x4 __attribute__((ext_vector_type(4)));
typedef float f32x16 __attribute__((ext_vector_type(16)));
typedef unsigned u32x4 __attribute__((ext_vector_type(4)));
typedef unsigned u32x2 __attribute__((ext_vector_type(2)));

constexpr int DM = 1024, NB = 8, SEQ = 4096, CTXL = 256, NLAT = NB * SEQ, NCTX = NB * CTXL, NTOK = NLAT + NCTX;
constexpr int LDT = NTOK;
constexpr float ALPHA_F = 1.681792830507429f;
constexpr float LN_EPS_F = 1e-5f;
constexpr int NPHASE = 22;
constexpr int FFT_N = 8192, FFT_PAD = 8704, FFT_BYTES = FFT_PAD * 8;
constexpr int LDS_BYTES = 2 * FFT_BYTES + 256;

constexpr size_t OFF_QKVZ = 0;
constexpr size_t OFF_VT = (size_t)NTOK * 3072 * 2;
constexpr size_t OFF_CIRC_LAT = 0, OFF_CIRC_CTX = (size_t)2 * 1024 * 8192 * 4;
constexpr size_t OFF_HOG = (size_t)NTOK * 4096 * 2;
constexpr size_t OFF_HLAT = OFF_HOG + (size_t)NTOK * 1024 * 2;
constexpr size_t OFF_HCTX = OFF_HLAT + (size_t)2 * 1024 * 8192 * 4;
constexpr size_t OFF_CTXBUF = OFF_HCTX + (size_t)2 * 1024 * 8192 * 4;
constexpr size_t OFF_WTIN = OFF_CTXBUF + (size_t)NCTX * 1024 * 4;
constexpr size_t OFF_WTOUT = OFF_WTIN + (size_t)4096 * 1024 * 2;
constexpr size_t OFF_MOD = OFF_WTOUT + (size_t)1024 * 1024 * 2;
constexpr size_t WS_END = OFF_MOD + (size_t)4 * 9 * 3072 * 4;

struct P {
    const float *x, *c, *ctx, *c_ctx, *w_ada, *b_ada, *w_in, *w_out, *ln_g, *ln_b, *na_rpb, *hy_conv_w, *hy_conv_b,
        *f_w1, *f_b1, *f_w2, *f_b2, *f_w3, *f_b3, *f_w4, *f_freq, *hy_skip;
    float* out; unsigned char* ws; int ph_lo, ph_hi;
};

__device__ __forceinline__ unsigned cvt_pk_bf16(float lo, float hi) { unsigned r; asm volatile("v_cvt_pk_bf16_f32 %0, %1, %2" : "=v"(r) : "v"(lo), "v"(hi)); return r; }
__device__ __forceinline__ float bf2f(unsigned short b) { return __uint_as_float(((unsigned)b) << 16); }
__device__ __forceinline__ float bflo(unsigned u) { return __uint_as_float(u << 16); }
__device__ __forceinline__ float bfhi(unsigned u) { return __uint_as_float(u & 0xffff0000u); }
__device__ __forceinline__ float wave_sum(float v) {
#pragma unroll
    for (int o = 32; o; o >>= 1) v += __shfl_xor(v, o, 64);
    return v;
}
__device__ __forceinline__ float sin_rev(float r) { return __builtin_amdgcn_sinf(r); }
__device__ __forceinline__ float cos_rev(float r) { return __builtin_amdgcn_cosf(r); }
__device__ __forceinline__ float fast_sin(float x) { return __builtin_amdgcn_sinf(x * 0.15915494309189535f); }
__device__ __forceinline__ float fast_exp(float x) { return __builtin_amdgcn_exp2f(x * 1.4426950408889634f); }
__device__ __forceinline__ float silu_f(float z) { return z * __builtin_amdgcn_rcpf(1.0f + fast_exp(-z)); }

constexpr int BM = 256, BK = 64, HALF = 128, HTB = HALF * BK * 2, NXCD = 8, WGM = 8;
__device__ __forceinline__ int lds_byte(int r, int c) { const int st = (r >> 4) * 2 + (c >> 5), rr = r & 15, cc = c & 31, ob = rr * 64 + cc * 2; return st * 1024 + (ob ^ (((ob >> 9) & 1) << 5)); }
__device__ __forceinline__ void stage_rc(int b, int& R, int& C) { const int st = b / 1024, sb = b % 1024, swz = sb ^ (((sb >> 9) & 1) << 5); R = (st >> 1) * 16 + swz / 64; C = (st & 1) * 32 + (swz % 64) / 2; }
__device__ __forceinline__ int perm32(int rho) { const int n = rho >> 4, i = rho & 15; return 8 * (i >> 2) + 4 * n + (i & 3); }

struct Unit { int pm, pn, sub; };
struct GSched {
    const char *A0, *B0, *A1, *B1; int nM0, nN0, nM1, nN1, G, c;
    __device__ __forceinline__ bool next(int i, Unit& u) const {
        long L = (long)i * G + c; const int n0 = nM0 * nN0; int sub = 0;
        if (L >= n0) { L -= n0; sub = 1; if (L >= (long)nM1 * nN1) return false; }
        const int nM = sub ? nM1 : nM0, nN = sub ? nN1 : nN0, nwg = nM * nN;
        int wgid = (int)L; { const int q = nwg / NXCD, r = nwg % NXCD, xcd = wgid % NXCD, off = wgid / NXCD; wgid = (xcd < r ? xcd * (q + 1) : r * (q + 1) + (xcd - r) * q) + off; }
        const int nig = WGM * nN, gid = wgid / nig, fm = gid * WGM, gsz = (nM - fm) < WGM ? (nM - fm) : WGM;
        u.pm = fm + ((wgid % nig) % gsz); u.pn = (wgid % nig) / gsz; u.sub = sub; return true;
    }
    __device__ __forceinline__ const char* aptr(const Unit& u) const { return (u.sub ? A1 : A0) + (size_t)u.pm * (256 * 1024 * 2); }
    __device__ __forceinline__ const char* bptr(const Unit& u) const { return (u.sub ? B1 : B0) + (size_t)u.pn * (256 * 1024 * 2); }
};

struct EpiStore {
    static constexpr bool PERM = true;
    bf16_t* O0; int ld0; bf16_t* O1; int ld1;
    __device__ __forceinline__ void operator()(const f32x4 (&acc)[2][2][4][2], const Unit& u, int wr, int wc, int fr, int fq) const {
        bf16_t* base = u.sub ? O1 : O0; const int ld = u.sub ? ld1 : ld0;
        const int row0 = u.pm * BM + wr * 64 + fr, col0 = u.pn * BM + wc * 32 + 8 * fq;
#pragma unroll
        for (int ai = 0; ai < 2; ++ai)
#pragma unroll
            for (int m = 0; m < 4; ++m) { bf16_t* rowp = base + (size_t)(row0 + ai * HALF + m * 16) * ld + col0;
#pragma unroll
                for (int bj = 0; bj < 2; ++bj) { const f32x4 v0 = acc[ai][bj][m][0], v1 = acc[ai][bj][m][1];
                    u32x4 o; o[0] = cvt_pk_bf16(v0[0], v0[1]); o[1] = cvt_pk_bf16(v0[2], v0[3]); o[2] = cvt_pk_bf16(v1[0], v1[1]); o[3] = cvt_pk_bf16(v1[2], v1[3]);
                    *(u32x4*)(rowp + bj * HALF) = o; } }
    }
};
struct EpiResid {
    static constexpr bool PERM = false;
    const float *lat_src, *ctx_src; float *lat_dst, *ctx_dst; const float* gate;
    __device__ __forceinline__ void operator()(const f32x4 (&acc)[2][2][4][2], const Unit& u, int wr, int wc, int fr, int fq) const {
        const int rt = u.pm * BM; const bool isc = rt >= NLAT;
        const float* src = isc ? ctx_src - (size_t)NLAT * DM : lat_src; float* dst = isc ? ctx_dst - (size_t)NLAT * DM : lat_dst;
        const float* g = gate + (isc ? 8 : (rt >> 12)) * 3072;
        const int row0 = rt + wr * 64 + fr, col0 = u.pn * BM + wc * 32 + 4 * fq;
        f32x4 gv[2][2];
#pragma unroll
        for (int bj = 0; bj < 2; ++bj)
#pragma unroll
            for (int n = 0; n < 2; ++n) gv[bj][n] = *(const f32x4*)(g + col0 + bj * HALF + n * 16);
#pragma unroll
        for (int ai = 0; ai < 2; ++ai)
#pragma unroll
            for (int m = 0; m < 4; ++m) { const size_t ro = (size_t)(row0 + ai * HALF + m * 16) * DM + col0;
#pragma unroll
                for (int bj = 0; bj < 2; ++bj)
#pragma unroll
                    for (int n = 0; n < 2; ++n) { const f32x4 xv = *(const f32x4*)(src + ro + bj * HALF + n * 16);
                        *(f32x4*)(dst + ro + bj * HALF + n * 16) = xv * ALPHA_F + gv[bj][n] * acc[ai][bj][m][n]; } }
    }
};

template <class Epi>
__device__ __forceinline__ void gemm_phase(int TID, LAS unsigned char* lds, const GSched& S, const Epi& E) {
    const int tid = TID, wid = __builtin_amdgcn_readfirstlane(tid >> 6), lane = tid & 63, wr = wid >> 2, wc = wid & 3, fr = lane & 15, fq = lane >> 4;
    constexpr int K = 1024, nt = K / BK;
    unsigned voffA[2], voffB[2];
#pragma unroll
    for (int i = 0; i < 2; ++i) { int R, C; stage_rc(tid * 16 + i * 8192, R, C); const int Rb = Epi::PERM ? ((R & ~31) + perm32(R & 31)) : R;
        voffA[i] = (unsigned)(R * K + C) * 2u; voffB[i] = (unsigned)(Rb * K + C) * 2u; }
    const size_t kstep = (size_t)(BK * 2), hstep = (size_t)HALF * K * 2;
    const unsigned ldsw = (unsigned)wid * 1024u;
    const int aoff = lds_byte(wr * 64 + fr, fq * 8), boff = lds_byte(wc * 32 + fr, fq * 8);
#define G_SA(b, h) (((b) * 2 + (h)) * HTB)
#define G_SB(b, h) ((4 + (b) * 2 + (h)) * HTB)
#define G_STAGE(bufoff, gbase, voff) do { _Pragma("unroll") for (int _i = 0; _i < 2; ++_i) \
        __builtin_amdgcn_global_load_lds((const unsigned*)((const char*)(gbase) + (voff)[_i]), (LAS unsigned*)(lds + (bufoff) + ldsw + _i * 8192), 16, 0, 0); } while (0)
#define G_LDA(dst, b, h) do { _Pragma("unroll") for (int m = 0; m < 4; ++m) _Pragma("unroll") for (int k = 0; k < 2; ++k) dst[m][k] = *(const LAS bf16x8*)(lds + G_SA(b, h) + aoff + m * 2048 + k * 1024); } while (0)
#define G_LDB(dst, b, h) do { _Pragma("unroll") for (int n = 0; n < 2; ++n) _Pragma("unroll") for (int k = 0; k < 2; ++k) dst[n][k] = *(const LAS bf16x8*)(lds + G_SB(b, h) + boff + n * 2048 + k * 1024); } while (0)
#define G_MMA(ai, bj, At, Bt) do { __builtin_amdgcn_s_setprio(1); _Pragma("unroll") for (int m = 0; m < 4; ++m) _Pragma("unroll") for (int n = 0; n < 2; ++n) _Pragma("unroll") for (int k = 0; k < 2; ++k) \
        acc[ai][bj][m][n] = __builtin_amdgcn_mfma_f32_16x16x32_bf16(Bt[n][k], At[m][k], acc[ai][bj][m][n], 0, 0, 0); __builtin_amdgcn_s_setprio(0); } while (0)
#define G_WAIT_V(n) asm volatile("s_waitcnt vmcnt(" #n ")" ::: "memory")
#define G_WAIT_L(n) asm volatile("s_waitcnt lgkmcnt(" #n ")" ::: "memory")
#define G_BAR __builtin_amdgcn_s_barrier()
#define G_SCHED __builtin_amdgcn_sched_barrier(0)
    Unit cur, nxt; int ui = 0;
    if (!S.next(0, cur)) return;
    f32x4 acc[2][2][4][2];
#pragma unroll
    for (int a = 0; a < 2; ++a)
#pragma unroll
        for (int b = 0; b < 2; ++b)
#pragma unroll
            for (int m = 0; m < 4; ++m)
#pragma unroll
                for (int n = 0; n < 2; ++n) acc[a][b][m][n] = (f32x4){0.f, 0.f, 0.f, 0.f};
    bf16x8 At[4][2], B0[2][2], B1[2][2];
    const char* cA = S.aptr(cur); const char* cB = S.bptr(cur);
    G_STAGE(G_SB(0, 0), cB, voffB); G_STAGE(G_SA(0, 0), cA, voffA); G_STAGE(G_SB(0, 1), cB + hstep, voffB); G_STAGE(G_SA(0, 1), cA + hstep, voffA);
    if (wr == 1) G_BAR;
    G_WAIT_V(4); G_BAR;
    G_STAGE(G_SB(1, 0), cB + kstep, voffB); G_STAGE(G_SA(1, 0), cA + kstep, voffA); G_STAGE(G_SB(1, 1), cB + hstep + kstep, voffB);
    G_WAIT_V(6); G_BAR;
    for (;;) {
        const bool has_next = S.next(ui + 1, nxt);
        const char* nA = has_next ? S.aptr(nxt) : cA; const char* nB = has_next ? S.bptr(nxt) : cB;
        for (int t = 0; t < nt; t += 2) {
            const bool last = (t == nt - 2);
            const char* a1 = cA + (size_t)(t + 1) * kstep;
            const char* a2 = last ? nA : cA + (size_t)(t + 2) * kstep; const char* b2 = last ? nB : cB + (size_t)(t + 2) * kstep;
            const char* a3 = a2 + kstep; const char* b3 = b2 + kstep;
            G_LDB(B0, 0, 0); G_SCHED; G_LDA(At, 0, 0); G_STAGE(G_SA(1, 1), a1 + hstep, voffA);
            G_WAIT_L(8); G_BAR; G_WAIT_L(0); G_MMA(0, 0, At, B0); G_BAR; G_SCHED;
            G_LDB(B1, 0, 1); G_STAGE(G_SB(0, 0), b2, voffB);
            G_BAR; G_WAIT_L(0); G_MMA(0, 1, At, B1); G_BAR;
            G_LDA(At, 0, 1); G_STAGE(G_SA(0, 0), a2, voffA);
            G_BAR; G_WAIT_L(0); G_MMA(1, 0, At, B0); G_BAR; G_SCHED;
            G_STAGE(G_SB(0, 1), b2 + hstep, voffB);
            G_WAIT_V(6); G_BAR; G_MMA(1, 1, At, B1); G_BAR;
            G_LDB(B0, 1, 0); G_SCHED; G_LDA(At, 1, 0); G_STAGE(G_SA(0, 1), a2 + hstep, voffA);
            G_WAIT_L(8); G_BAR; G_WAIT_L(0); G_MMA(0, 0, At, B0); G_BAR; G_SCHED;
            G_LDB(B1, 1, 1); G_STAGE(G_SB(1, 0), b3, voffB);
            G_BAR; G_WAIT_L(0); G_MMA(0, 1, At, B1); G_BAR;
            G_LDA(At, 1, 1); G_STAGE(G_SA(1, 0), a3, voffA);
            G_BAR; G_WAIT_L(0); G_MMA(1, 0, At, B0); G_BAR; G_SCHED;
            G_STAGE(G_SB(1, 1), b3 + hstep, voffB);
            G_WAIT_V(6); G_BAR; G_MMA(1, 1, At, B1); G_BAR;
        }
        E(acc, cur, wr, wc, fr, fq);
        if (!has_next) break;
#pragma unroll
        for (int a = 0; a < 2; ++a)
#pragma unroll
            for (int b = 0; b < 2; ++b)
#pragma unroll
                for (int m = 0; m < 4; ++m)
#pragma unroll
                    for (int n = 0; n < 2; ++n) acc[a][b][m][n] = (f32x4){0.f, 0.f, 0.f, 0.f};
        cur = nxt; cA = nA; cB = nB; ++ui;
    }
    G_WAIT_V(0);
    if (wr == 0) G_BAR;
    G_BAR;
#undef G_SA
#undef G_SB
#undef G_STAGE
#undef G_LDA
#undef G_LDB
#undef G_MMA
#undef G_WAIT_V
#undef G_WAIT_L
#undef G_BAR
#undef G_SCHED
}

__device__ __forceinline__ void phase_ada(int TID, int BID, const P& p, unsigned char* smem) {
    float* sc = (float*)smem; float* red = sc + 9 * 1024;
    const int tid = TID;
    for (int idx = tid; idx < 9 * 1024; idx += 512) { const int b = idx >> 10, k = idx & 1023; const float c = b < 8 ? p.c[b * 1024 + k] : p.c_ctx[k]; sc[idx] = c / (1.0f + __expf(-c)); }
    __syncthreads();
    float* mod = (float*)(p.ws + OFF_MOD);
    for (int item = BID; item < 192; item += gridDim.x) {
        const int layer = item / 48, chunk = item % 48, cl = tid & 63, kq = tid >> 6, col = chunk * 64 + cl;
        const float* w = p.w_ada + (size_t)layer * 1024 * 3072 + col;
        float acc[9];
#pragma unroll
        for (int b = 0; b < 9; ++b) acc[b] = 0.f;
        for (int k = kq * 128; k < kq * 128 + 128; ++k) { const float wv = w[(size_t)k * 3072];
#pragma unroll
            for (int b = 0; b < 9; ++b) acc[b] += sc[b * 1024 + k] * wv; }
#pragma unroll
        for (int b = 0; b < 9; ++b) red[(kq * 9 + b) * 64 + cl] = acc[b];
        __syncthreads();
        for (int o = tid; o < 576; o += 512) { const int b = o >> 6, cc = o & 63; float s = p.b_ada[layer * 3072 + chunk * 64 + cc];
#pragma unroll
            for (int q = 0; q < 8; ++q) s += red[(q * 9 + b) * 64 + cc];
            mod[(size_t)(layer * 9 + b) * 3072 + chunk * 64 + cc] = s; }
        __syncthreads();
    }
}

__device__ __forceinline__ void lnmod_rows(int TID, int BID, const P& p, int layer, int ntok) {
    const int tid = TID, lane = tid & 63, wid = tid >> 6;
    const float* mod = (const float*)(p.ws + OFF_MOD) + (size_t)layer * 9 * 3072;
    float* ctxbuf = (float*)(p.ws + OFF_CTXBUF);
    bf16_t* hog = (bf16_t*)(p.ws + OFF_HOG);
    for (int row = BID * 8 + wid; row < ntok; row += gridDim.x * 8) {
        const bool isc = row >= NLAT;
        float* xb = isc ? ctxbuf + (size_t)(row - NLAT) * DM : p.out + (size_t)row * DM;
        const float* src = layer == 0 ? (isc ? p.ctx + (size_t)(row - NLAT) * DM : p.x + (size_t)row * DM) : xb;
        f32x4 v[4];
#pragma unroll
        for (int e = 0; e < 4; ++e) v[e] = *(const f32x4*)(src + lane * 4 + 256 * e);
        if (layer > 0) {
            float s = 0.f;
#pragma unroll
            for (int e = 0; e < 4; ++e) s += v[e][0] + v[e][1] + v[e][2] + v[e][3];
            const float mu = wave_sum(s) * (1.0f / 1024.0f);
            float q = 0.f;
#pragma unroll
            for (int e = 0; e < 4; ++e)
#pragma unroll
                for (int i = 0; i < 4; ++i) { const float d = v[e][i] - mu; q += d * d; }
            const float rstd = rsqrtf(wave_sum(q) * (1.0f / 1024.0f) + LN_EPS_F);
            const float* g = p.ln_g + (size_t)(layer - 1) * DM; const float* bb = p.ln_b + (size_t)(layer - 1) * DM;
#pragma unroll
            for (int e = 0; e < 4; ++e) { const f32x4 gv = *(const f32x4*)(g + lane * 4 + 256 * e), bv = *(const f32x4*)(bb + lane * 4 + 256 * e);
                v[e] = (v[e] - mu) * rstd * gv + bv; *(f32x4*)(xb + lane * 4 + 256 * e) = v[e]; }
        }
        const float* mrow = mod + (size_t)(isc ? 8 : (row >> 12)) * 3072;
#pragma unroll
        for (int e = 0; e < 4; ++e) { const int col = lane * 4 + 256 * e; const f32x4 sh = *(const f32x4*)(mrow + col), scl = *(const f32x4*)(mrow + 1024 + col);
            const f32x4 h = v[e] * (scl + 1.0f) + sh; u32x2 o; o[0] = cvt_pk_bf16(h[0], h[1]); o[1] = cvt_pk_bf16(h[2], h[3]);
            *(u32x2*)(hog + (size_t)row * DM + col) = o; }
    }
}
__device__ __forceinline__ void wconv_tiles(int TID, int BID, const P& p, int layer, bool na, unsigned char* smem) {
    float* tile = (float*)smem;
    const int tid = TID;
    for (int t = BID; t < 1280; t += gridDim.x) {
        const float* W; int N, kt, ntl; bf16_t* dst; const bool isin = t < 1024;
        if (isin) { W = p.w_in + (size_t)layer * 1024 * 4096; N = 4096; dst = (bf16_t*)(p.ws + OFF_WTIN); kt = t >> 6; ntl = t & 63; }
        else { const int t2 = t - 1024; W = p.w_out + (size_t)layer * 1024 * 1024; N = 1024; dst = (bf16_t*)(p.ws + OFF_WTOUT); kt = t2 >> 4; ntl = t2 & 15; }
#pragma unroll
        for (int i = 0; i < 2; ++i) { const int idx = tid + i * 512, r = idx >> 4, c4 = idx & 15;
            const f32x4 v = *(const f32x4*)(W + (size_t)(kt * 64 + r) * N + ntl * 64 + c4 * 4);
#pragma unroll
            for (int e = 0; e < 4; ++e) tile[r * 65 + c4 * 4 + e] = v[e]; }
        __syncthreads();
        { const int nl = tid >> 3, kg = tid & 7; int n = ntl * 64 + nl;
          if (na && isin) { if (n >= 3072) n -= 1024; else if (n >= 2048) n += 1024; }
          float f[8];
#pragma unroll
          for (int e = 0; e < 8; ++e) f[e] = tile[(kg * 8 + e) * 65 + nl];
          u32x4 o; o[0] = cvt_pk_bf16(f[0], f[1]); o[1] = cvt_pk_bf16(f[2], f[3]); o[2] = cvt_pk_bf16(f[4], f[5]); o[3] = cvt_pk_bf16(f[6], f[7]);
          *(u32x4*)(dst + (size_t)n * 1024 + kt * 64 + kg * 8) = o; }
        __syncthreads();
    }
}
__device__ __forceinline__ void filter_taps(int TID, int BID, const P& p, int j, bool with_ctx, unsigned char* smem) {
    float* zf = (float*)smem; float* a1 = zf + 32 * 33; float* a2 = a1 + 32 * 65; float* a3 = a2 + 32 * 65;
    const int tid = TID, lane = tid & 63, wid = tid >> 6;
    const int nitems = 512 + (with_ctx ? 32 : 0);
    const float *w1 = p.f_w1 + (size_t)j * 33 * 64, *b1 = p.f_b1 + j * 64, *w2 = p.f_w2 + (size_t)j * 4096, *b2 = p.f_b2 + j * 64, *w3 = p.f_w3 + (size_t)j * 4096, *b3 = p.f_b3 + j * 64,
                *w4 = p.f_w4 + (size_t)j * 64 * 4096, *fq = p.f_freq + j * 192;
    float* circ_lat = (float*)(p.ws + OFF_CIRC_LAT); float* circ_ctx = (float*)(p.ws + OFF_CIRC_CTX);
    for (int it = (int)gridDim.x - 1 - BID; it < nitems; it += gridDim.x) {
        const bool isctx = it >= 512; const int it2 = isctx ? it - 512 : it, ptile = it2 >> 2, cq = it2 & 3, L = isctx ? 256 : 4096;
        for (int idx = tid; idx < 32 * 33; idx += 512) { const int pos = idx / 33, e = idx % 33, i = ptile * 32 + pos; float val;
            if (e == 0) val = (float)i / (float)(L - 1);
            else { const int band = (e - 1) & 15; const float f = 1e-4f + (float)band * ((15.0f - 1e-4f) / 15.0f); const float rev = f * (float)i / (float)L; val = e <= 16 ? cos_rev(rev) : -sin_rev(rev); }
            zf[idx] = val; }
        __syncthreads();
        { const int pos = tid >> 4;
#pragma unroll 1
          for (int r = 0; r < 4; ++r) { const int o = (tid & 15) + 16 * r; float acc = b1[o];
#pragma unroll 3
              for (int e = 0; e < 33; ++e) acc += zf[pos * 33 + e] * w1[e * 64 + o]; a1[pos * 65 + o] = fast_sin(fq[o] * acc); }
          __syncthreads();
#pragma unroll 1
          for (int r = 0; r < 4; ++r) { const int o = (tid & 15) + 16 * r; float acc = b2[o];
#pragma unroll 4
              for (int e = 0; e < 64; ++e) acc += a1[pos * 65 + e] * w2[e * 64 + o]; a2[pos * 65 + o] = fast_sin(fq[64 + o] * acc); }
          __syncthreads();
#pragma unroll 1
          for (int r = 0; r < 4; ++r) { const int o = (tid & 15) + 16 * r; float acc = b3[o];
#pragma unroll 4
              for (int e = 0; e < 64; ++e) acc += a2[pos * 65 + e] * w3[e * 64 + o]; a3[pos * 65 + o] = fast_sin(fq[128 + o] * acc); }
          __syncthreads(); }
        const int pc = lane & 31, kh = lane >> 5;
        float bq[32];
#pragma unroll
        for (int s = 0; s < 32; ++s) bq[s] = a3[pc * 65 + 2 * s + kh];
        const int i = ptile * 32 + pc; const float tpos = (float)i / (float)(L - 1);
#pragma unroll 1
        for (int tt = 0; tt < 4; ++tt) {
            const int ch0 = (cq * 32 + wid * 4 + tt) * 32;
            f32x16 acc;
#pragma unroll
            for (int v = 0; v < 16; ++v) acc[v] = 0.f;
#pragma unroll
            for (int s = 0; s < 32; ++s) { const float a = w4[(size_t)(2 * s + kh) * 4096 + ch0 + pc]; acc = __builtin_amdgcn_mfma_f32_32x32x2f32(a, bq[s], acc, 0, 0, 0); }
            const int o = ch0 >> 11, d = (ch0 >> 10) & 1, wb = ch0 & 1023;
#pragma unroll
            for (int v = 0; v < 16; ++v) { const int w = wb + 8 * (v >> 2) + 4 * kh + (v & 3);
                const float delta = fabsf(-3.0701134573253945f + (-15.350567286626973f + 3.0701134573253945f) * ((float)w * (1.0f / 1023.0f)));
                const float val = acc[v] * __expf(-tpos * delta);
                if (!(d == 1 && i == 0)) { if (!isctx) circ_lat[(size_t)(o * 1024 + w) * 8192 + (d ? 8192 - i : i)] = val; else circ_ctx[(size_t)(o * 1024 + w) * 512 + (d ? 512 - i : i)] = val; } }
        }
        __syncthreads();
    }
}

__device__ __forceinline__ int phys(int pp) { return ((pp & ~15) | ((pp ^ (pp >> 4)) & 15)) + ((pp >> 8) << 4); }
__device__ __forceinline__ constexpr int brev(int x, int bits) { int r = 0; for (int i = 0; i < bits; ++i) r |= ((x >> i) & 1) << (bits - 1 - i); return r; }
__device__ __forceinline__ constexpr float tw_c(int i) {
    constexpr float T[16] = {1.0f, 0.98078528040323043f, 0.92387953251128674f, 0.83146961230254524f, 0.70710678118654757f, 0.55557023301960229f, 0.38268343236508984f, 0.19509032201612833f,
                             0.0f, -0.19509032201612833f, -0.38268343236508984f, -0.55557023301960229f, -0.70710678118654757f, -0.83146961230254524f, -0.92387953251128674f, -0.98078528040323043f};
    return T[i];
}
__device__ __forceinline__ constexpr float tw_s(int i) {
    constexpr float T[16] = {0.0f, 0.19509032201612825f, 0.38268343236508978f, 0.55557023301960218f, 0.70710678118654746f, 0.83146961230254524f, 0.92387953251128674f, 0.98078528040323043f,
                             1.0f, 0.98078528040323043f, 0.92387953251128674f, 0.83146961230254546f, 0.70710678118654757f, 0.55557023301960218f, 0.38268343236508989f, 0.19509032201612861f};
    return T[i];
}
template <int R, int S> __device__ __forceinline__ void dif_stage(float (&re)[R], float (&im)[R]) {
#pragma unroll
    for (int b = 0; b < R; b += 2 * S)
#pragma unroll
        for (int jj = 0; jj < S; ++jj) { const int i0 = b + jj, i1 = i0 + S, ti = jj * (16 / S);
            const float ur = re[i0], ui = im[i0], vr = re[i1], vi = im[i1]; re[i0] = ur + vr; im[i0] = ui + vi; const float dr = ur - vr, di = ui - vi;
            if (ti == 0) { re[i1] = dr; im[i1] = di; } else if (ti == 8) { re[i1] = di; im[i1] = -dr; }
            else { const float c = tw_c(ti), s = tw_s(ti); re[i1] = dr * c + di * s; im[i1] = di * c - dr * s; } }
}
template <int R, int S> __device__ __forceinline__ void dit_stage(float (&re)[R], float (&im)[R]) {
#pragma unroll
    for (int b = 0; b < R; b += 2 * S)
#pragma unroll
        for (int jj = 0; jj < S; ++jj) { const int i0 = b + jj, i1 = i0 + S, ti = jj * (16 / S);
            const float ur = re[i0], ui = im[i0], xr = re[i1], xi = im[i1]; float vr, vi;
            if (ti == 0) { vr = xr; vi = xi; } else if (ti == 8) { vr = -xi; vi = xr; }
            else { const float c = tw_c(ti), s = tw_s(ti); vr = xr * c - xi * s; vi = xr * s + xi * c; }
            re[i0] = ur + vr; im[i0] = ui + vi; re[i1] = ur - vr; im[i1] = ui - vi; }
}
__device__ __forceinline__ void dif16(float (&re)[16], float (&im)[16]) { dif_stage<16, 8>(re, im); dif_stage<16, 4>(re, im); dif_stage<16, 2>(re, im); dif_stage<16, 1>(re, im); }
__device__ __forceinline__ void dit16(float (&re)[16], float (&im)[16]) { dit_stage<16, 1>(re, im); dit_stage<16, 2>(re, im); dit_stage<16, 4>(re, im); dit_stage<16, 8>(re, im); }

template <bool CONJ> __device__ __forceinline__ void tw8192(float& xr, float& xi, int j, int m) {
    const float rev = (float)((j * m) & 8191) * (1.0f / 8192.0f), c = cos_rev(rev), s = sin_rev(rev);
    if (!CONJ) { const float tr = xr * c + xi * s; xi = xi * c - xr * s; xr = tr; } else { const float tr = xr * c - xi * s; xi = xr * s + xi * c; xr = tr; }
}
template <bool FULL> __device__ __forceinline__ void fft_p1(float2* buf, int j) {
    asm volatile("" : "+v"(j));
    float2* bj = buf + phys(j);
    float ar[16], ai[16], dr[16], di[16];
#pragma unroll
    for (int k = 0; k < 16; ++k) { const float2 v = bj[272 * k]; ar[k] = v.x; ai[k] = v.y; }
    if (FULL) {
#pragma unroll
        for (int k = 0; k < 16; ++k) { const float2 v = bj[272 * (k + 16)]; dr[k] = ar[k] - v.x; di[k] = ai[k] - v.y; ar[k] += v.x; ai[k] += v.y; }
    } else {
#pragma unroll
        for (int k = 0; k < 16; ++k) { dr[k] = ar[k]; di[k] = ai[k]; }
    }
    dif16(ar, ai);
#pragma unroll
    for (int i = 0; i < 16; ++i) { const int m = 2 * brev(i, 4); float xr = ar[i], xi = ai[i]; if (m != 0) tw8192<false>(xr, xi, j, m); bj[272 * m] = make_float2(xr, xi); }
#pragma unroll
    for (int k = 1; k < 16; ++k) { const float ur = dr[k], ui = di[k];
        if (k == 8) { dr[k] = ui; di[k] = -ur; } else { const float c = tw_c(k), s = tw_s(k); dr[k] = ur * c + ui * s; di[k] = ui * c - ur * s; } }
    dif16(dr, di);
#pragma unroll
    for (int i = 0; i < 16; ++i) { const int m = 2 * brev(i, 4) + 1; float xr = dr[i], xi = di[i]; tw8192<false>(xr, xi, j, m); bj[272 * m] = make_float2(xr, xi); }
}
__device__ __forceinline__ void fft_p2(float2* buf, int j) {
    asm volatile("" : "+v"(j));
#pragma unroll 1
    for (int i = 0; i < 2; ++i) { const int q = j + 256 * i, base = (q >> 4) * 256 + (q & 15), jj = q & 15;
        float re[16], im[16];
#pragma unroll
        for (int k = 0; k < 16; ++k) { const float2 v = buf[phys(base + 16 * k)]; re[k] = v.x; im[k] = v.y; }
        dif16(re, im);
#pragma unroll
        for (int idx = 0; idx < 16; ++idx) { const int m = brev(idx, 4); float xr = re[idx], xi = im[idx];
            if (m != 0) { const float rev = (float)((jj * m) & 255) * (1.0f / 256.0f), c = cos_rev(rev), s = sin_rev(rev); const float tr = xr * c + xi * s; xi = xi * c - xr * s; xr = tr; }
            buf[phys(base + 16 * m)] = make_float2(xr, xi); } }
}
__device__ __forceinline__ void fft_p3_mul_ia(float2* buf, int j, const unsigned* __restrict__ H) {
    asm volatile("" : "+v"(j));
#pragma unroll 1
    for (int i = 0; i < 2; ++i) { const int q = j + 256 * i;
        u32x4 hr[4];
#pragma unroll
        for (int e = 0; e < 4; ++e) hr[e] = *(const u32x4*)(H + 16 * q + 4 * e);
        float re[16], im[16];
#pragma unroll
        for (int k = 0; k < 16; ++k) { const float2 v = buf[phys(16 * q + k)]; re[k] = v.x; im[k] = v.y; }
        dif16(re, im);
#pragma unroll
        for (int idx = 0; idx < 16; ++idx) { const int m = brev(idx, 4); const unsigned hu = hr[m >> 2][m & 3];
            const float hx = __half2float(__ushort_as_half((unsigned short)(hu & 0xffffu))), hy = __half2float(__ushort_as_half((unsigned short)(hu >> 16)));
            const float xr = re[idx], xi = im[idx]; re[idx] = xr * hx - xi * hy; im[idx] = xr * hy + xi * hx; }
        dit16(re, im);
#pragma unroll
        for (int k = 0; k < 16; ++k) buf[phys(16 * q + k)] = make_float2(re[k], im[k]); }
}
__device__ __forceinline__ void fft_ib(float2* buf, int j) {
    asm volatile("" : "+v"(j));
#pragma unroll 1
    for (int i = 0; i < 2; ++i) { const int q = j + 256 * i, base = (q >> 4) * 256 + (q & 15), jj = q & 15;
        float re[16], im[16];
#pragma unroll
        for (int m = 0; m < 16; ++m) { const int idx = brev(m, 4); const float2 v = buf[phys(base + 16 * m)]; float xr = v.x, xi = v.y;
            if (m != 0) { const float rev = (float)((jj * m) & 255) * (1.0f / 256.0f), c = cos_rev(rev), s = sin_rev(rev); const float tr = xr * c - xi * s; xi = xr * s + xi * c; xr = tr; }
            re[idx] = xr; im[idx] = xi; }
        dit16(re, im);
#pragma unroll
        for (int k = 0; k < 16; ++k) buf[phys(base + 16 * k)] = make_float2(re[k], im[k]); }
}
__device__ __forceinline__ void fft_ic(float2* buf, int j) {
    asm volatile("" : "+v"(j));
    float2* bj = buf + phys(j);
    float ur[16], ui[16], vr[16], vi[16];
#pragma unroll
    for (int mm = 0; mm < 16; ++mm) { const int idx = brev(mm, 4), m = 2 * mm; const float2 v = bj[272 * m]; float xr = v.x, xi = v.y; if (m != 0) tw8192<true>(xr, xi, j, m); ur[idx] = xr; ui[idx] = xi; }
    dit16(ur, ui);
#pragma unroll
    for (int mm = 0; mm < 16; ++mm) { const int idx = brev(mm, 4), m = 2 * mm + 1; const float2 v = bj[272 * m]; float xr = v.x, xi = v.y; tw8192<true>(xr, xi, j, m); vr[idx] = xr; vi[idx] = xi; }
    dit16(vr, vi);
#pragma unroll
    for (int k = 0; k < 16; ++k) { float xr = vr[k], xi = vi[k];
        if (k == 8) { const float t = -xi; xi = xr; xr = t; } else if (k != 0) { const float c = tw_c(k), s = tw_s(k); const float t = xr * c - xi * s; xi = xr * s + xi * c; xr = t; }
        bj[272 * k] = make_float2(ur[k] + xr, ui[k] + xi); }
}
__device__ __forceinline__ void conv_core(float2* buf, int j, const unsigned* H) {
    fft_p1<false>(buf, j); __syncthreads();
    fft_p2(buf, j); __syncthreads();
    fft_p3_mul_ia(buf, j, H); __syncthreads();
    fft_ib(buf, j); __syncthreads();
    fft_ic(buf, j); __syncthreads();
}

__device__ __forceinline__ void phase_f2(int TID, int BID, const P& p, bool with_ctx, unsigned char* smem) {
    const int tid = TID, grp = tid >> 8, j = tid & 255, lane = tid & 63, wg = (tid >> 6) & 3;
    float2* buf = (float2*)(smem + grp * FFT_BYTES); float* red = (float*)(smem + 2 * FFT_BYTES) + grp * 8;
    const int nitems = with_ctx ? 4096 : 2048, nrounds = (nitems + 2 * (int)gridDim.x - 1) / (2 * (int)gridDim.x);
    const float* circ_lat = (const float*)(p.ws + OFF_CIRC_LAT); const float* circ_ctx = (const float*)(p.ws + OFF_CIRC_CTX);
    for (int rd = 0; rd < nrounds; ++rd) {
        const int item = (rd * (int)gridDim.x + BID) * 2 + grp; const bool active = item < nitems, isctx = item >= 2048; const int ow = item & 2047;
        float lo[16], hi[16];
#pragma unroll
        for (int k = 0; k < 16; ++k) { lo[k] = 0.f; hi[k] = 0.f; }
        if (active) {
            if (!isctx) { const float* src = circ_lat + (size_t)ow * 8192;
#pragma unroll
                for (int e = 0; e < 4; ++e) { const f32x4 a = *(const f32x4*)(src + 16 * j + 4 * e), b = *(const f32x4*)(src + 4096 + 16 * j + 4 * e);
#pragma unroll
                    for (int i = 0; i < 4; ++i) { lo[4 * e + i] = a[i]; hi[4 * e + i] = b[i]; } }
                if (j == 0) hi[0] = 0.f;
            } else { const float* src = circ_ctx + (size_t)ow * 512;
                if (j < 16) {
#pragma unroll
                    for (int e = 0; e < 4; ++e) { const f32x4 a = *(const f32x4*)(src + 16 * j + 4 * e);
#pragma unroll
                        for (int i = 0; i < 4; ++i) lo[4 * e + i] = a[i]; } }
                if (j >= 240) {
#pragma unroll
                    for (int e = 0; e < 4; ++e) { const f32x4 b = *(const f32x4*)(src + 16 * j - 3584 + 4 * e);
#pragma unroll
                        for (int i = 0; i < 4; ++i) hi[4 * e + i] = b[i]; }
                    if (j == 240) hi[0] = 0.f; }
            }
        }
        float s = 0.f;
#pragma unroll
        for (int k = 0; k < 16; ++k) s += fabsf(lo[k]) + fabsf(hi[k]);
        s = wave_sum(s);
        if (lane == 0) red[wg] = s;
#pragma unroll
        for (int k = 0; k < 16; ++k) { buf[phys(16 * j + k)] = make_float2(lo[k], 0.f); buf[phys(4096 + 16 * j + k)] = make_float2(hi[k], 0.f); }
        __syncthreads();
        const float inv = 1.0f / (red[0] + red[1] + red[2] + red[3]);
        fft_p1<true>(buf, j); __syncthreads();
        fft_p2(buf, j); __syncthreads();
        unsigned* Hd = (unsigned*)(p.ws + (isctx ? OFF_HCTX : OFF_HLAT)) + (size_t)ow * 8192;
#pragma unroll 1
        for (int i = 0; i < 2; ++i) { const int q = j + 256 * i;
            float re[16], im[16];
#pragma unroll
            for (int k = 0; k < 16; ++k) { const float2 v = buf[phys(16 * q + k)]; re[k] = v.x; im[k] = v.y; }
            dif16(re, im);
            unsigned hp[16];
#pragma unroll
            for (int idx = 0; idx < 16; ++idx) { const int m = brev(idx, 4);
                hp[m] = (unsigned)__half_as_ushort(__float2half_rn(re[idx] * inv)) | ((unsigned)__half_as_ushort(__float2half_rn(im[idx] * inv)) << 16); }
            if (active) {
#pragma unroll
                for (int e = 0; e < 4; ++e) { u32x4 o; o[0] = hp[4 * e]; o[1] = hp[4 * e + 1]; o[2] = hp[4 * e + 2]; o[3] = hp[4 * e + 3]; *(u32x4*)(Hd + 16 * q + 4 * e) = o; } } }
        __syncthreads();
    }
}

__device__ __forceinline__ void load_row16(const bf16_t* seq, int t0, int L, bool valid, float (&v)[18]) {
    if (valid) { const u32x4 a = *(const u32x4*)(seq + t0), b = *(const u32x4*)(seq + t0 + 8);
#pragma unroll
        for (int e = 0; e < 4; ++e) { v[1 + 2 * e] = bflo(a[e]); v[2 + 2 * e] = bfhi(a[e]); v[9 + 2 * e] = bflo(b[e]); v[10 + 2 * e] = bfhi(b[e]); }
        v[0] = t0 > 0 ? bf2f(seq[t0 - 1]) : 0.f; v[17] = (t0 + 16 < L) ? bf2f(seq[t0 + 16]) : 0.f;
    } else {
#pragma unroll
        for (int k = 0; k < 18; ++k) v[k] = 0.f; }
}
__device__ __forceinline__ void short_conv16(const bf16_t* seq, int t0, int L, bool valid, float w0, float w1, float w2, float bias, float (&o)[16]) {
    float v[18]; load_row16(seq, t0, L, valid, v);
#pragma unroll
    for (int k = 0; k < 16; ++k) o[k] = valid ? (w0 * v[k] + w1 * v[k + 1] + w2 * v[k + 2] + bias) : 0.f;
}
__device__ __forceinline__ void phase_conv(int TID, int BID, const P& p, int jh, bool with_ctx, unsigned char* smem) {
    const int tid = TID, grp = tid >> 8, j = tid & 255;
    float2* buf = (float2*)(smem + grp * FFT_BYTES);
    const int nitems = 4096 + (with_ctx ? 1024 : 0), nrounds = (nitems + 2 * (int)gridDim.x - 1) / (2 * (int)gridDim.x);
    bf16_t* projT = (bf16_t*)(p.ws + OFF_QKVZ);
    const float* cw = p.hy_conv_w + (size_t)jh * 3 * 3072; const float* cb = p.hy_conv_b + (size_t)jh * 3072; const float* skip = p.hy_skip + (size_t)jh * 2 * 1024;
    for (int rd = 0; rd < nrounds; ++rd) {
        const int item = (rd * (int)gridDim.x + BID) * 2 + grp; const bool active = item < nitems, isctx = item >= 4096;
        int c, t0, L, offRe, offIm; bool vRe, vIm;
        if (!isctx) { c = item >> 2; const int pair = item & 3; t0 = 16 * j; L = 4096; offRe = (2 * pair) * 4096; offIm = offRe + 4096; vRe = active; vIm = active; }
        else { c = item - 4096; t0 = 16 * (j & 31); L = 256; offRe = NLAT + (j >> 5) * 256; offIm = offRe; vRe = active && ((j & 31) < 16); vIm = false; }
        if (!active) c = 0;
        const bf16_t* rv = projT + (size_t)c * LDT; const bf16_t* rx1 = projT + (size_t)(1024 + c) * LDT; const bf16_t* rx2 = projT + (size_t)(2048 + c) * LDT; bf16_t* rg = projT + (size_t)(3072 + c) * LDT;
        const unsigned* H0 = (const unsigned*)(p.ws + (isctx ? OFF_HCTX : OFF_HLAT)) + (size_t)c * 8192; const unsigned* H1 = H0 + (size_t)1024 * 8192;
        float zr[16], zi[16];
        short_conv16(rv + offRe, t0, L, vRe, cw[c], cw[3072 + c], cw[6144 + c], cb[c], zr);
        short_conv16(rv + offIm, t0, L, vIm, cw[c], cw[3072 + c], cw[6144 + c], cb[c], zi);
#pragma unroll
        for (int k = 0; k < 16; ++k) buf[phys(16 * j + k)] = make_float2(zr[k], zi[k]);
        __syncthreads();
        conv_core(buf, j, H0);
        { float xr[16], xi[16]; const float sk = skip[c];
          short_conv16(rx1 + offRe, t0, L, vRe, cw[1024 + c], cw[3072 + 1024 + c], cw[6144 + 1024 + c], cb[1024 + c], xr);
          short_conv16(rx1 + offIm, t0, L, vIm, cw[1024 + c], cw[3072 + 1024 + c], cw[6144 + 1024 + c], cb[1024 + c], xi);
#pragma unroll
          for (int k = 0; k < 16; ++k) { const float2 y = buf[phys(16 * j + k)];
              zr[k] = xr[k] * (y.x * (1.0f / 8192.0f) + zr[k] * sk); zi[k] = xi[k] * (y.y * (1.0f / 8192.0f) + zi[k] * sk);
              buf[phys(16 * j + k)] = make_float2(zr[k], zi[k]); } }
        __syncthreads();
        conv_core(buf, j, H1);
        { float xr[16], xi[16]; const float sk = skip[1024 + c];
          short_conv16(rx2 + offRe, t0, L, vRe, cw[2048 + c], cw[3072 + 2048 + c], cw[6144 + 2048 + c], cb[2048 + c], xr);
          short_conv16(rx2 + offIm, t0, L, vIm, cw[2048 + c], cw[3072 + 2048 + c], cw[6144 + 2048 + c], cb[2048 + c], xi);
#pragma unroll
          for (int k = 0; k < 16; ++k) { const float2 y = buf[phys(16 * j + k)];
              zr[k] = xr[k] * (y.x * (1.0f / 8192.0f) + zr[k] * sk); zi[k] = xi[k] * (y.y * (1.0f / 8192.0f) + zi[k] * sk); } }
        if (vRe) { bf16_t* gp = rg + offRe + t0; const u32x4 a = *(const u32x4*)gp, b = *(const u32x4*)(gp + 8); u32x4 oa, ob;
#pragma unroll
            for (int e = 0; e < 4; ++e) { oa[e] = cvt_pk_bf16(zr[2 * e] * silu_f(bflo(a[e])), zr[2 * e + 1] * silu_f(bfhi(a[e]))); ob[e] = cvt_pk_bf16(zr[8 + 2 * e] * silu_f(bflo(b[e])), zr[9 + 2 * e] * silu_f(bfhi(b[e]))); }
            *(u32x4*)gp = oa; *(u32x4*)(gp + 8) = ob; }
        if (vIm) { bf16_t* gp = rg + offIm + t0; const u32x4 a = *(const u32x4*)gp, b = *(const u32x4*)(gp + 8); u32x4 oa, ob;
#pragma unroll
            for (int e = 0; e < 4; ++e) { oa[e] = cvt_pk_bf16(zi[2 * e] * silu_f(bflo(a[e])), zi[2 * e + 1] * silu_f(bfhi(a[e]))); ob[e] = cvt_pk_bf16(zi[8 + 2 * e] * silu_f(bflo(b[e])), zi[9 + 2 * e] * silu_f(bfhi(b[e]))); }
            *(u32x4*)gp = oa; *(u32x4*)(gp + 8) = ob; }
    }
}

__device__ __forceinline__ void phase_transpose(int TID, int BID, const P& p, int ntok, unsigned char* smem) {
    bf16_t* tile = (bf16_t*)smem;
    const int tid = TID; const bf16_t* src = (const bf16_t*)(p.ws + OFF_QKVZ) + (size_t)3072 * LDT; bf16_t* og = (bf16_t*)(p.ws + OFF_HOG);
    const int ntt = ntok / 64, ntiles = 16 * ntt;
    for (int t = BID; t < ntiles; t += gridDim.x) { const int ct = t / ntt, tt = t % ntt;
        { const int r = tid >> 3, ch = tid & 7; const u32x4 v = *(const u32x4*)(src + (size_t)(ct * 64 + r) * LDT + tt * 64 + ch * 8); *(u32x4*)(tile + r * 72 + ch * 8) = v; }
        __syncthreads();
        { const int tk = tid >> 3, cg8 = tid & 7; unsigned short e[8];
#pragma unroll
          for (int i = 0; i < 8; ++i) e[i] = tile[(cg8 * 8 + i) * 72 + tk];
          u32x4 o; o[0] = e[0] | ((unsigned)e[1] << 16); o[1] = e[2] | ((unsigned)e[3] << 16); o[2] = e[4] | ((unsigned)e[5] << 16); o[3] = e[6] | ((unsigned)e[7] << 16);
          *(u32x4*)(og + (size_t)(tt * 64 + tk) * DM + ct * 64 + cg8 * 8) = o; }
        __syncthreads();
    }
}

template <bool LAT>
__device__ __forceinline__ void att_wave(int TID, const bf16_t* __restrict__ qkz, const bf16_t* __restrict__ vt, bf16_t* __restrict__ og, const float* rpb, int b, int h, int qtok0, int r, int n) {
    constexpr int NT = LAT ? 32 : 16;
    const int lane = TID & 63, c = lane & 15, g = lane >> 4;
    const int r0 = min(max(r - 4, 0), 56), bs = min(max(16 * n - 8, 0), 32);
    const bf16_t* qrow = qkz + (size_t)(qtok0 + c) * 3072 + h * 64 + 8 * g;
    const bf16x8 q0 = *(const bf16x8*)qrow, q1 = *(const bf16x8*)(qrow + 32);
    const int lat0 = b * 4096 + r0 * 64 + bs, ctx0 = NLAT + b * 256;
    f32x4 S[NT];
#pragma unroll
    for (int T = 0; T < NT; ++T) {
        const int ktok0 = (LAT && T < 16) ? lat0 + (T >> 1) * 64 + (T & 1) * 16 : ctx0 + 16 * (T - (LAT ? 16 : 0));
        const bf16_t* krow = qkz + (size_t)(ktok0 + c) * 3072 + 1024 + h * 64 + 8 * g;
        const bf16x8 k0 = *(const bf16x8*)krow, k1 = *(const bf16x8*)(krow + 32);
        f32x4 a = (f32x4){0.f, 0.f, 0.f, 0.f};
        a = __builtin_amdgcn_mfma_f32_16x16x32_bf16(k0, q0, a, 0, 0, 0);
        a = __builtin_amdgcn_mfma_f32_16x16x32_bf16(k1, q1, a, 0, 0, 0);
        S[T] = a;
    }
    float mx = -3.0e38f;
#pragma unroll
    for (int T = 0; T < NT; ++T) {
        if (LAT && T < 16) { const int i = T >> 1, hh = T & 1, cq = 16 * n + c, qs = min(max(cq - 8, 0), 48); const float* brow = rpb + (r0 + i - r + 7) * 31;
#pragma unroll
            for (int jj = 0; jj < 4; ++jj) { const int kc = bs + 16 * hh + 4 * g + jj; const bool ok = kc >= qs && kc < qs + 16; const int dc = min(max(kc - cq + 15, 0), 30);
                S[T][jj] = ok ? S[T][jj] * 0.125f + brow[dc] : -1.0e30f; }
        } else {
#pragma unroll
            for (int jj = 0; jj < 4; ++jj) S[T][jj] *= 0.125f; }
#pragma unroll
        for (int jj = 0; jj < 4; ++jj) mx = fmaxf(mx, S[T][jj]);
    }
    mx = fmaxf(mx, __shfl_xor(mx, 16, 64)); mx = fmaxf(mx, __shfl_xor(mx, 32, 64));
    float sum = 0.f; const float mb = mx * 1.4426950408889634f;
#pragma unroll
    for (int T = 0; T < NT; ++T)
#pragma unroll
        for (int jj = 0; jj < 4; ++jj) { const float e = __builtin_amdgcn_exp2f(S[T][jj] * 1.4426950408889634f - mb); S[T][jj] = e; sum += e; }
    sum += __shfl_xor(sum, 16, 64); sum += __shfl_xor(sum, 32, 64);
    f32x4 acc[4];
#pragma unroll
    for (int db = 0; db < 4; ++db) acc[db] = (f32x4){0.f, 0.f, 0.f, 0.f};
    const bf16_t* vbase = vt + (size_t)(h * 64 + c) * LDT + 4 * g;
#pragma unroll
    for (int ks = 0; ks < NT / 2; ++ks) {
        const int T0 = 2 * ks; const int vtok0 = (LAT && T0 < 16) ? lat0 + (T0 >> 1) * 64 : ctx0 + 16 * (T0 - (LAT ? 16 : 0));
        union { u32x4 u; bf16x8 v; } pb; pb.u[0] = cvt_pk_bf16(S[T0][0], S[T0][1]); pb.u[1] = cvt_pk_bf16(S[T0][2], S[T0][3]); pb.u[2] = cvt_pk_bf16(S[T0 + 1][0], S[T0 + 1][1]); pb.u[3] = cvt_pk_bf16(S[T0 + 1][2], S[T0 + 1][3]);
#pragma unroll
        for (int db = 0; db < 4; ++db) { const bf16_t* vp = vbase + (size_t)(16 * db) * LDT + vtok0;
            union { u32x4 u; bf16x8 v; } va; const u32x2 lo = *(const u32x2*)vp, hi = *(const u32x2*)(vp + 16); va.u[0] = lo[0]; va.u[1] = lo[1]; va.u[2] = hi[0]; va.u[3] = hi[1];
            acc[db] = __builtin_amdgcn_mfma_f32_16x16x32_bf16(va.v, pb.v, acc[db], 0, 0, 0); }
    }
    const float inv = 1.0f / sum;
    const bf16_t* zrow = qkz + (size_t)(qtok0 + c) * 3072 + 2048 + h * 64 + 4 * g; bf16_t* orow = og + (size_t)(qtok0 + c) * DM + h * 64 + 4 * g;
#pragma unroll
    for (int db = 0; db < 4; ++db) { const u32x2 zz = *(const u32x2*)(zrow + 16 * db); u32x2 o;
        o[0] = cvt_pk_bf16(acc[db][0] * inv * silu_f(bflo(zz[0])), acc[db][1] * inv * silu_f(bfhi(zz[0])));
        o[1] = cvt_pk_bf16(acc[db][2] * inv * silu_f(bflo(zz[1])), acc[db][3] * inv * silu_f(bfhi(zz[1])));
        *(u32x2*)(orow + 16 * db) = o; }
}
__device__ __forceinline__ void phase_att(int TID, int BID, const P& p, int jn, unsigned char* smem) {
    float* rpb = (float*)smem;
    const int tid = TID, wid = tid >> 6;
    const bf16_t* qkz = (const bf16_t*)(p.ws + OFF_QKVZ); const bf16_t* vt = (const bf16_t*)(p.ws + OFF_VT); bf16_t* og = (bf16_t*)(p.ws + OFF_HOG);
    for (int item = BID; item < 4352; item += gridDim.x) {
        const bool isctx = item >= 4096; int b, h, rp;
        if (!isctx) { rp = item & 31; h = (item >> 5) & 15; b = item >> 9; } else { const int i2 = item - 4096; rp = i2 & 1; h = (i2 >> 1) & 15; b = i2 >> 5; }
        __syncthreads();
        if (tid < 465) rpb[tid] = p.na_rpb[((size_t)jn * 16 + h) * 465 + tid];
        __syncthreads();
        if (!isctx) { const int r = 2 * rp + (wid >> 2), n = wid & 3; att_wave<true>(TID, qkz, vt, og, rpb, b, h, b * 4096 + r * 64 + 16 * n, r, n); }
        else att_wave<false>(TID, qkz, vt, og, rpb, b, h, NLAT + b * 256 + 16 * (8 * rp + wid), 0, 0);
    }
}

__device__ __forceinline__ void phase_final_ln(int TID, int BID, const P& p) {
    const int tid = TID, lane = tid & 63, wid = tid >> 6;
    const float* g = p.ln_g + 3 * DM; const float* bb = p.ln_b + 3 * DM;
    for (int row = BID * 8 + wid; row < NLAT; row += gridDim.x * 8) {
        float* xb = p.out + (size_t)row * DM; f32x4 v[4];
#pragma unroll
        for (int e = 0; e < 4; ++e) v[e] = *(const f32x4*)(xb + lane * 4 + 256 * e);
        float s = 0.f;
#pragma unroll
        for (int e = 0; e < 4; ++e) s += v[e][0] + v[e][1] + v[e][2] + v[e][3];
        const float mu = wave_sum(s) * (1.0f / 1024.0f);
        float q = 0.f;
#pragma unroll
        for (int e = 0; e < 4; ++e)
#pragma unroll
            for (int i = 0; i < 4; ++i) { const float d = v[e][i] - mu; q += d * d; }
        const float rstd = rsqrtf(wave_sum(q) * (1.0f / 1024.0f) + LN_EPS_F);
#pragma unroll
        for (int e = 0; e < 4; ++e) { const f32x4 gv = *(const f32x4*)(g + lane * 4 + 256 * e), bv = *(const f32x4*)(bb + lane * 4 + 256 * e); *(f32x4*)(xb + lane * 4 + 256 * e) = (v[e] - mu) * rstd * gv + bv; }
    }
}

__device__ __forceinline__ void phase_g1(int TID, int BID, const P& p, int layer, bool na, int ntok, unsigned char* smem) {
    GSched S; const char* h = (const char*)(p.ws + OFF_HOG); const char* wt = (const char*)(p.ws + OFF_WTIN);
    S.G = gridDim.x; S.c = BID;
    EpiStore E;
    if (na) { S.A0 = h; S.B0 = wt; S.nM0 = ntok / 256; S.nN0 = 12; S.A1 = wt + (size_t)3072 * 1024 * 2; S.B1 = h; S.nM1 = 4; S.nN1 = ntok / 256;
        E.O0 = (bf16_t*)(p.ws + OFF_QKVZ); E.ld0 = 3072; E.O1 = (bf16_t*)(p.ws + OFF_VT); E.ld1 = LDT; }
    else { S.A0 = wt; S.B0 = h; S.nM0 = 16; S.nN0 = ntok / 256; S.A1 = wt; S.B1 = h; S.nM1 = 0; S.nN1 = 0;
        E.O0 = (bf16_t*)(p.ws + OFF_QKVZ); E.ld0 = LDT; E.O1 = E.O0; E.ld1 = LDT; }
    gemm_phase<EpiStore>(TID, (LAS unsigned char*)smem, S, E);
}
__device__ __forceinline__ void phase_g2(int TID, int BID, const P& p, int layer, int ntok, unsigned char* smem) {
    GSched S; S.G = gridDim.x; S.c = BID;
    S.A0 = (const char*)(p.ws + OFF_HOG); S.B0 = (const char*)(p.ws + OFF_WTOUT); S.nM0 = ntok / 256; S.nN0 = 4; S.A1 = S.A0; S.B1 = S.B0; S.nM1 = 0; S.nN1 = 0;
    EpiResid E; float* ctxbuf = (float*)(p.ws + OFF_CTXBUF);
    E.lat_src = layer == 0 ? p.x : p.out; E.ctx_src = layer == 0 ? p.ctx : ctxbuf; E.lat_dst = p.out; E.ctx_dst = ctxbuf;
    E.gate = (const float*)(p.ws + OFF_MOD) + (size_t)layer * 9 * 3072 + 2048;
    gemm_phase<EpiResid>(TID, (LAS unsigned char*)smem, S, E);
}
__device__ __forceinline__ void run_phase(int TID, int BID, const P& p, int ph, unsigned char* smem) {
    if (ph == 0) { phase_ada(TID, BID, p, smem); return; }
    if (ph == NPHASE - 1) { phase_final_ln(TID, BID, p); return; }
    const int q = ph - 1, lp = q / 10, r = q % 10;
    if (r < 4) { const int layer = 2 * lp;
        if (r == 0) { lnmod_rows(TID, BID, p, layer, NTOK); wconv_tiles(TID, BID, p, layer, true, smem); }
        else if (r == 1) phase_g1(TID, BID, p, layer, true, NTOK, smem);
        else if (r == 2) phase_att(TID, BID, p, lp, smem);
        else phase_g2(TID, BID, p, layer, NTOK, smem);
    } else { const int layer = 2 * lp + 1, r2 = r - 4; const bool last = layer == 3; const int ntok = last ? NLAT : NTOK;
        if (r2 == 0) { lnmod_rows(TID, BID, p, layer, ntok); wconv_tiles(TID, BID, p, layer, false, smem); filter_taps(TID, BID, p, lp, !last, smem); }
        else if (r2 == 1) phase_f2(TID, BID, p, !last, smem);
        else if (r2 == 2) phase_g1(TID, BID, p, layer, false, ntok, smem);
        else if (r2 == 3) phase_conv(TID, BID, p, lp, !last, smem);
        else if (r2 == 4) phase_transpose(TID, BID, p, ntok, smem);
        else phase_g2(TID, BID, p, layer, ntok, smem);
    }
}

__global__ void __launch_bounds__(512) fwd_mega(P p) {
    extern __shared__ __attribute__((aligned(16))) unsigned char smem[];
    cg::grid_group grid = cg::this_grid();
    for (int ph = p.ph_lo; ph < p.ph_hi; ++ph) {
        int TID = threadIdx.x, BID = blockIdx.x;
        asm volatile("" : "+v"(TID));
        asm volatile("" : "+s"(BID));
        run_phase(TID, BID, p, ph, smem);
        if (ph + 1 < p.ph_hi) grid.sync();
    }
}

extern "C" void kernel_launch(void* const* d_in, const int* in_sizes, int n_in, void* d_out, int out_size, void* d_ws, size_t ws_size, hipStream_t stream) {
    static int grid_blocks = 0;
    if (grid_blocks == 0) {
        if (n_in != 22 || ws_size < WS_END) { fprintf(stderr, "kernel_launch: unexpected n_in %d or ws_size %zu (< %zu)\n", n_in, ws_size, (size_t)WS_END); grid_blocks = -1; return; }
        int dev = 0, cus = 0, per_cu = 0;
        (void)hipGetDevice(&dev); (void)hipDeviceGetAttribute(&cus, hipDeviceAttributeMultiprocessorCount, dev);
        if (hipFuncSetAttribute((const void*)fwd_mega, hipFuncAttributeMaxDynamicSharedMemorySize, LDS_BYTES) != hipSuccess) { fprintf(stderr, "kernel_launch: hipFuncSetAttribute failed\n"); grid_blocks = -1; return; }
        if (hipOccupancyMaxActiveBlocksPerMultiprocessor(&per_cu, (const void*)fwd_mega, 512, LDS_BYTES) != hipSuccess || per_cu < 1) { fprintf(stderr, "kernel_launch: occupancy query failed (%d)\n", per_cu); (void)hipGetLastError(); grid_blocks = -1; return; }
        grid_blocks = cus * per_cu;
        if (grid_blocks > 256) grid_blocks = 256;
    }
    if (grid_blocks < 0) return;
    P p{};
    const float** f = (const float**)&p;
    for (int i = 0; i < 22; ++i) f[i] = (const float*)d_in[i];
    p.out = (float*)d_out; p.ws = (unsigned char*)d_ws;
#if SINGLE_LAUNCH
    p.ph_lo = 0; p.ph_hi = NPHASE;
    void* args[] = {&p};
    hipError_t e = hipLaunchCooperativeKernel((const void*)fwd_mega, dim3(grid_blocks), dim3(512), args, LDS_BYTES, stream);
    if (e != hipSuccess) fprintf(stderr, "cooperative launch failed: %s (grid %d)\n", hipGetErrorString(e), grid_blocks);
#else
    for (int ph = 0; ph < NPHASE; ++ph) { p.ph_lo = ph; p.ph_hi = ph + 1; hipLaunchKernelGGL(fwd_mega, dim3(grid_blocks), dim3(512), LDS_BYTES, stream, p); }
#endif
}
```

```cpp
#include <hip/hip_runtime.h>
#include <hip/hip_cooperative_groups.h>
#include <hip/hip_fp16.h>
#include <cstdio>
namespace cg = cooperative_groups;

#ifndef SINGLE_LAUNCH
#define SINGLE_LAUNCH 1
#endif

#ifndef PROBE_KIND
#define PROBE_KIND -1
#endif
#ifndef DEBUG_CHECK
#define DEBUG_CHECK 0
#endif
#define LAS __attribute__((address_space(3)))
typedef unsigned short bf16_t;
typedef short bf16x8 __attribute__((ext_vector_type(8)));
typedef short bf16x4 __attribute__((ext_vector_type(4)));
typedef float f32x4 __attribute__((ext_vector_type(4)));
typedef float f32x16 __attribute__((ext_vector_type(16)));
typedef unsigned u32x4 __attribute__((ext_vector_type(4)));
typedef unsigned u32x2 __attribute__((ext_vector_type(2)));
typedef float f32x2 __attribute__((ext_vector_type(2)));

constexpr int DM = 1024, NB = 8, SEQ = 4096, CTXL = 256, NLAT = NB * SEQ, NCTX = NB * CTXL, NTOK = NLAT + NCTX;
constexpr int LDT = NTOK;
constexpr float ALPHA_F = 1.681792830507429f;
constexpr float LN_EPS_F = 1e-5f;
constexpr int NPHASE = 22;
constexpr int FFT_N = 8192, FFT_PAD = 8704, FFT_BYTES = FFT_PAD * 8;
constexpr int LDS_BYTES = 2 * FFT_BYTES + 256;

constexpr size_t OFF_QKVZ = 0;
constexpr size_t OFF_VT = (size_t)NTOK * 3072 * 2;
constexpr size_t OFF_Y = (size_t)136 << 20;
constexpr size_t OFF_CIRC_LAT = 0, OFF_CIRC_CTX = (size_t)2 * 1024 * 8192 * 4;
constexpr size_t OFF_HOG = (size_t)NTOK * 4096 * 2;
constexpr size_t OFF_HLAT = OFF_HOG + (size_t)NTOK * 1024 * 2;
constexpr size_t OFF_HCTX = OFF_HLAT + (size_t)2 * 1024 * 8192 * 4;
constexpr size_t OFF_CTXBUF = OFF_HCTX + (size_t)2 * 1024 * 8192 * 4;
constexpr size_t OFF_WTIN = OFF_CTXBUF + (size_t)NCTX * 1024 * 4;
constexpr size_t OFF_WTOUT = OFF_WTIN + (size_t)4096 * 1024 * 2;
constexpr size_t OFF_MOD = OFF_WTOUT + (size_t)1024 * 1024 * 2;
constexpr size_t OFF_A3 = OFF_MOD + (size_t)4 * 9 * 3072 * 4;
constexpr size_t OFF_BAR = OFF_A3 + (size_t)2 * 4352 * 64 * 4;
constexpr size_t WS_END = OFF_BAR + (size_t)3456 * 4;

struct P {
    const float *x, *c, *ctx, *c_ctx, *w_ada, *b_ada, *w_in, *w_out, *ln_g, *ln_b, *na_rpb, *hy_conv_w, *hy_conv_b,
        *f_w1, *f_b1, *f_w2, *f_b2, *f_w3, *f_b3, *f_w4, *f_freq, *hy_skip;
    float* out; unsigned char* ws; int ph_lo, ph_hi;
};

__device__ __forceinline__ unsigned cvt_pk_bf16(float lo, float hi) { unsigned r; asm volatile("v_cvt_pk_bf16_f32 %0, %1, %2" : "=v"(r) : "v"(lo), "v"(hi)); return r; }
__device__ __forceinline__ float bf2f(unsigned short b) { return __uint_as_float(((unsigned)b) << 16); }
__device__ __forceinline__ float bflo(unsigned u) { return __uint_as_float(u << 16); }
__device__ __forceinline__ float bfhi(unsigned u) { return __uint_as_float(u & 0xffff0000u); }
__device__ __forceinline__ float wave_sum(float v) {
#pragma unroll
    for (int o = 32; o; o >>= 1) v += __shfl_xor(v, o, 64);
    return v;
}
__device__ __forceinline__ float sin_rev(float r) { return __builtin_amdgcn_sinf(r); }
__device__ __forceinline__ float cos_rev(float r) { return __builtin_amdgcn_cosf(r); }
__device__ __forceinline__ float fast_sin(float x) { return __builtin_amdgcn_sinf(x * 0.15915494309189535f); }
__device__ __forceinline__ float fast_exp(float x) { return __builtin_amdgcn_exp2f(x * 1.4426950408889634f); }
__device__ __forceinline__ float silu_f(float z) { return z * __builtin_amdgcn_rcpf(1.0f + fast_exp(-z)); }

constexpr int BM = 256, BK = 64, HALF = 128, HTB = HALF * BK * 2, NXCD = 8, WGM = 8;
__device__ __forceinline__ int lds_byte(int r, int c) { const int st = (r >> 4) * 2 + (c >> 5), rr = r & 15, cc = c & 31, ob = rr * 64 + cc * 2; return st * 1024 + (ob ^ (((ob >> 9) & 1) << 5)); }
__device__ __forceinline__ void stage_rc(int b, int& R, int& C) { const int st = b / 1024, sb = b % 1024, swz = sb ^ (((sb >> 9) & 1) << 5); R = (st >> 1) * 16 + swz / 64; C = (st & 1) * 32 + (swz % 64) / 2; }
__device__ __forceinline__ int perm32(int rho) { const int n = rho >> 4, i = rho & 15; return 8 * (i >> 2) + 4 * n + (i & 3); }

struct Unit { int pm, pn, sub; };
struct GSched {
    const char *A0, *B0, *A1, *B1; int nM0, nN0, nM1, nN1, G, c;
    __device__ __forceinline__ bool next(int i, Unit& u) const {
        long L = (long)i * G + c; const int n0 = nM0 * nN0; int sub = 0;
        if (L >= n0) { L -= n0; sub = 1; if (L >= (long)nM1 * nN1) return false; }
        const int nM = sub ? nM1 : nM0, nN = sub ? nN1 : nN0, nwg = nM * nN;
        int wgid = (int)L; { const int q = nwg / NXCD, r = nwg % NXCD, xcd = wgid % NXCD, off = wgid / NXCD; wgid = (xcd < r ? xcd * (q + 1) : r * (q + 1) + (xcd - r) * q) + off; }
        const int nig = WGM * nN, gid = wgid / nig, fm = gid * WGM, gsz = (nM - fm) < WGM ? (nM - fm) : WGM;
        u.pm = fm + ((wgid % nig) % gsz); u.pn = (wgid % nig) / gsz; u.sub = sub; return true;
    }
    __device__ __forceinline__ const char* aptr(const Unit& u) const { return (u.sub ? A1 : A0) + (size_t)u.pm * (256 * 1024 * 2); }
    __device__ __forceinline__ const char* bptr(const Unit& u) const { return (u.sub ? B1 : B0) + (size_t)u.pn * (256 * 1024 * 2); }
};

struct EpiStore {
    static constexpr bool PERM = true;
    bf16_t* O0; int ld0; bf16_t* O1; int ld1;
    __device__ __forceinline__ void operator()(const f32x4 (&acc)[2][2][4][2], const Unit& u, int wr, int wc, int fr, int fq) const {
        bf16_t* base = u.sub ? O1 : O0; const int ld = u.sub ? ld1 : ld0;
        const int row0 = u.pm * BM + wr * 64 + fr, col0 = u.pn * BM + wc * 32 + 8 * fq;
#pragma unroll
        for (int ai = 0; ai < 2; ++ai)
#pragma unroll
            for (int m = 0; m < 4; ++m) { bf16_t* rowp = base + (size_t)(row0 + ai * HALF + m * 16) * ld + col0;
#pragma unroll
                for (int bj = 0; bj < 2; ++bj) { const f32x4 v0 = acc[ai][bj][m][0], v1 = acc[ai][bj][m][1];
                    u32x4 o; o[0] = cvt_pk_bf16(v0[0], v0[1]); o[1] = cvt_pk_bf16(v0[2], v0[3]); o[2] = cvt_pk_bf16(v1[0], v1[1]); o[3] = cvt_pk_bf16(v1[2], v1[3]);
                    *(u32x4*)(rowp + bj * HALF) = o; } }
    }
};
template <class Epi>
__device__ __forceinline__ void gemm_phase(int TID, LAS unsigned char* lds, const GSched& S, const Epi& E) {
    const int tid = TID, wid = __builtin_amdgcn_readfirstlane(tid >> 6), lane = tid & 63, wr = wid >> 2, wc = wid & 3, fr = lane & 15, fq = lane >> 4;
    constexpr int K = 1024, nt = K / BK;
    unsigned voffA[2], voffB[2];
#pragma unroll
    for (int i = 0; i < 2; ++i) { int R, C; stage_rc(tid * 16 + i * 8192, R, C); const int Rb = Epi::PERM ? ((R & ~31) + perm32(R & 31)) : R;
        voffA[i] = (unsigned)(R * K + C) * 2u; voffB[i] = (unsigned)(Rb * K + C) * 2u; }
    const size_t kstep = (size_t)(BK * 2), hstep = (size_t)HALF * K * 2;
    const unsigned ldsw = (unsigned)wid * 1024u;
    const int aoff = lds_byte(wr * 64 + fr, fq * 8), boff = lds_byte(wc * 32 + fr, fq * 8);
#define G_SA(b, h) (((b) * 2 + (h)) * HTB)
#define G_SB(b, h) ((4 + (b) * 2 + (h)) * HTB)
#define G_STAGE(bufoff, gbase, voff) do { _Pragma("unroll") for (int _i = 0; _i < 2; ++_i) \
        __builtin_amdgcn_global_load_lds((const unsigned*)((const char*)(gbase) + (voff)[_i]), (LAS unsigned*)(lds + (bufoff) + ldsw + _i * 8192), 16, 0, 0); } while (0)
#define G_LDA(dst, b, h) do { _Pragma("unroll") for (int m = 0; m < 4; ++m) _Pragma("unroll") for (int k = 0; k < 2; ++k) dst[m][k] = *(const LAS bf16x8*)(lds + G_SA(b, h) + aoff + m * 2048 + k * 1024); } while (0)
#define G_LDB(dst, b, h) do { _Pragma("unroll") for (int n = 0; n < 2; ++n) _Pragma("unroll") for (int k = 0; k < 2; ++k) dst[n][k] = *(const LAS bf16x8*)(lds + G_SB(b, h) + boff + n * 2048 + k * 1024); } while (0)
#define G_MMA(ai, bj, At, Bt) do { __builtin_amdgcn_s_setprio(1); _Pragma("unroll") for (int m = 0; m < 4; ++m) _Pragma("unroll") for (int n = 0; n < 2; ++n) _Pragma("unroll") for (int k = 0; k < 2; ++k) \
        acc[ai][bj][m][n] = __builtin_amdgcn_mfma_f32_16x16x32_bf16(Bt[n][k], At[m][k], acc[ai][bj][m][n], 0, 0, 0); __builtin_amdgcn_s_setprio(0); } while (0)
#define G_WAIT_V(n) asm volatile("s_waitcnt vmcnt(" #n ")" ::: "memory")
#define G_WAIT_L(n) asm volatile("s_waitcnt lgkmcnt(" #n ")" ::: "memory")
#define G_BAR __builtin_amdgcn_s_barrier()
#define G_SCHED __builtin_amdgcn_sched_barrier(0)
    Unit cur, nxt; int ui = 0;
    if (!S.next(0, cur)) return;
    f32x4 acc[2][2][4][2];
#pragma unroll
    for (int a = 0; a < 2; ++a)
#pragma unroll
        for (int b = 0; b < 2; ++b)
#pragma unroll
            for (int m = 0; m < 4; ++m)
#pragma unroll
                for (int n = 0; n < 2; ++n) acc[a][b][m][n] = (f32x4){0.f, 0.f, 0.f, 0.f};
    bf16x8 At[4][2], B0[2][2], B1[2][2];
    const char* cA = S.aptr(cur); const char* cB = S.bptr(cur);
    G_STAGE(G_SB(0, 0), cB, voffB); G_STAGE(G_SA(0, 0), cA, voffA); G_STAGE(G_SB(0, 1), cB + hstep, voffB); G_STAGE(G_SA(0, 1), cA + hstep, voffA);
    if (wr == 1) G_BAR;
    G_WAIT_V(4); G_BAR;
    G_STAGE(G_SB(1, 0), cB + kstep, voffB); G_STAGE(G_SA(1, 0), cA + kstep, voffA); G_STAGE(G_SB(1, 1), cB + hstep + kstep, voffB);
    G_WAIT_V(6); G_BAR;
    for (;;) {
        const bool has_next = S.next(ui + 1, nxt);
        const char* nA = has_next ? S.aptr(nxt) : cA; const char* nB = has_next ? S.bptr(nxt) : cB;
        for (int t = 0; t < nt; t += 2) {
            const bool last = (t == nt - 2);
            const char* a1 = cA + (size_t)(t + 1) * kstep;
            const char* a2 = last ? nA : cA + (size_t)(t + 2) * kstep; const char* b2 = last ? nB : cB + (size_t)(t + 2) * kstep;
            const char* a3 = a2 + kstep; const char* b3 = b2 + kstep;
            G_LDB(B0, 0, 0); G_SCHED; G_LDA(At, 0, 0); G_STAGE(G_SA(1, 1), a1 + hstep, voffA);
            G_WAIT_L(8); G_BAR; G_WAIT_L(0); G_MMA(0, 0, At, B0); G_BAR; G_SCHED;
            G_LDB(B1, 0, 1); G_STAGE(G_SB(0, 0), b2, voffB);
            G_BAR; G_WAIT_L(0); G_MMA(0, 1, At, B1); G_BAR;
            G_LDA(At, 0, 1); G_STAGE(G_SA(0, 0), a2, voffA);
            G_BAR; G_WAIT_L(0); G_MMA(1, 0, At, B0); G_BAR; G_SCHED;
            G_STAGE(G_SB(0, 1), b2 + hstep, voffB);
            G_WAIT_V(6); G_BAR; G_MMA(1, 1, At, B1); G_BAR;
            G_LDB(B0, 1, 0); G_SCHED; G_LDA(At, 1, 0); G_STAGE(G_SA(0, 1), a2 + hstep, voffA);
            G_WAIT_L(8); G_BAR; G_WAIT_L(0); G_MMA(0, 0, At, B0); G_BAR; G_SCHED;
            G_LDB(B1, 1, 1); G_STAGE(G_SB(1, 0), b3, voffB);
            G_BAR; G_WAIT_L(0); G_MMA(0, 1, At, B1); G_BAR;
            G_LDA(At, 1, 1); G_STAGE(G_SA(1, 0), a3, voffA);
            G_BAR; G_WAIT_L(0); G_MMA(1, 0, At, B0); G_BAR; G_SCHED;
            G_STAGE(G_SB(1, 1), b3 + hstep, voffB);
            G_WAIT_V(6); G_BAR; G_MMA(1, 1, At, B1); G_BAR;
        }
        E(acc, cur, wr, wc, fr, fq);
        if (!has_next) break;
#pragma unroll
        for (int a = 0; a < 2; ++a)
#pragma unroll
            for (int b = 0; b < 2; ++b)
#pragma unroll
                for (int m = 0; m < 4; ++m)
#pragma unroll
                    for (int n = 0; n < 2; ++n) acc[a][b][m][n] = (f32x4){0.f, 0.f, 0.f, 0.f};
        cur = nxt; cA = nA; cB = nB; ++ui;
    }
    G_WAIT_V(0);
    if (wr == 0) G_BAR;
    G_BAR;
#undef G_SA
#undef G_SB
#undef G_STAGE
#undef G_LDA
#undef G_LDB
#undef G_MMA
#undef G_WAIT_V
#undef G_WAIT_L
#undef G_BAR
#undef G_SCHED
}

__device__ __forceinline__ void phase_ada(int TID, int BID, const P& p, unsigned char* smem) {
    float* sc = (float*)smem; float* red = sc + 9 * 1024;
    const int tid = TID;
    for (int idx = tid; idx < 9 * 1024; idx += 512) { const int b = idx >> 10, k = idx & 1023; const float c = b < 8 ? p.c[b * 1024 + k] : p.c_ctx[k]; sc[idx] = c / (1.0f + __expf(-c)); }
    __syncthreads();
    float* mod = (float*)(p.ws + OFF_MOD);
    for (int item = BID; item < 192; item += gridDim.x) {
        const int layer = item / 48, chunk = item % 48, cl = tid & 63, kq = tid >> 6, col = chunk * 64 + cl;
        const float* w = p.w_ada + (size_t)layer * 1024 * 3072 + col;
        float acc[9];
#pragma unroll
        for (int b = 0; b < 9; ++b) acc[b] = 0.f;
        for (int k = kq * 128; k < kq * 128 + 128; ++k) { const float wv = w[(size_t)k * 3072];
#pragma unroll
            for (int b = 0; b < 9; ++b) acc[b] += sc[b * 1024 + k] * wv; }
#pragma unroll
        for (int b = 0; b < 9; ++b) red[(kq * 9 + b) * 64 + cl] = acc[b];
        __syncthreads();
        for (int o = tid; o < 576; o += 512) { const int b = o >> 6, cc = o & 63; float s = p.b_ada[layer * 3072 + chunk * 64 + cc];
#pragma unroll
            for (int q = 0; q < 8; ++q) s += red[(q * 9 + b) * 64 + cc];
            mod[(size_t)(layer * 9 + b) * 3072 + chunk * 64 + cc] = s; }
        __syncthreads();
    }
}

__device__ __forceinline__ void lnmod_rows(int TID, int BID, const P& p, int layer, int ntok) {
    const int tid = TID, lane = tid & 63, wid = tid >> 6;
    const float* modb = (const float*)(p.ws + OFF_MOD);
    float* ctxbuf = (float*)(p.ws + OFF_CTXBUF);
    bf16_t* hog = (bf16_t*)(p.ws + OFF_HOG); const bf16_t* Y = (const bf16_t*)(p.ws + OFF_Y);
    const int nwv = gridDim.x * 8, wrank = BID * 8 + wid;
    const bool contig = (ntok % nwv) == 0; const int per = contig ? ntok / nwv : (ntok - wrank + nwv - 1) / nwv;
#define LN_ROW(k) (contig ? wrank * per + (k) : wrank + (k) * nwv)
#define LN_SRC(r) (layer <= 1 ? ((r) >= NLAT ? p.ctx + (size_t)((r) - NLAT) * DM : p.x + (size_t)(r) * DM) : ((r) >= NLAT ? ctxbuf + (size_t)((r) - NLAT) * DM : p.out + (size_t)(r) * DM))
    f32x4 vn[4]; u32x2 yn[4];
    f32x4 lg[4], lb[4], gt[4], sh[4], sc[4]; int bcur = -1;
    if (layer > 0) { const float* g = p.ln_g + (size_t)(layer - 1) * DM; const float* bb = p.ln_b + (size_t)(layer - 1) * DM;
#pragma unroll
        for (int e = 0; e < 4; ++e) { lg[e] = *(const f32x4*)(g + lane * 4 + 256 * e); lb[e] = *(const f32x4*)(bb + lane * 4 + 256 * e); } }
    if (per > 0) { const int row = LN_ROW(0); const float* src = LN_SRC(row);
#pragma unroll
        for (int e = 0; e < 4; ++e) { vn[e] = __builtin_nontemporal_load((const f32x4*)(src + lane * 4 + 256 * e)); if (layer > 0) yn[e] = __builtin_nontemporal_load((const u32x2*)(Y + (size_t)row * DM + lane * 4 + 256 * e)); } }
    for (int k = 0; k < per; ++k) {
        const int row = LN_ROW(k);
        const bool isc = row >= NLAT; const int bsel = isc ? 8 : (row >> 12);
        float* xb = isc ? ctxbuf + (size_t)(row - NLAT) * DM : p.out + (size_t)row * DM;
        f32x4 v[4]; u32x2 yc[4];
#pragma unroll
        for (int e = 0; e < 4; ++e) { v[e] = vn[e]; yc[e] = yn[e]; }
        if (k + 1 < per) { const int nrow = LN_ROW(k + 1); const float* src = LN_SRC(nrow);
#pragma unroll
            for (int e = 0; e < 4; ++e) { vn[e] = __builtin_nontemporal_load((const f32x4*)(src + lane * 4 + 256 * e)); if (layer > 0) yn[e] = __builtin_nontemporal_load((const u32x2*)(Y + (size_t)nrow * DM + lane * 4 + 256 * e)); } }
        if (bsel != bcur) { bcur = bsel;
            const float* grow = modb + (size_t)((layer > 0 ? layer - 1 : 0) * 9 + bsel) * 3072 + 2048; const float* mrow = modb + (size_t)((layer < 4 ? layer : 0) * 9 + bsel) * 3072;
#pragma unroll
            for (int e = 0; e < 4; ++e) { const int col = lane * 4 + 256 * e; if (layer > 0) gt[e] = *(const f32x4*)(grow + col); if (layer < 4) { sh[e] = *(const f32x4*)(mrow + col); sc[e] = *(const f32x4*)(mrow + 1024 + col); } } }
        if (layer > 0) {
#pragma unroll
            for (int e = 0; e < 4; ++e) { const u32x2 yy = yc[e];
                f32x4 yv; yv[0] = bflo(yy[0]); yv[1] = bfhi(yy[0]); yv[2] = bflo(yy[1]); yv[3] = bfhi(yy[1]);
                v[e] = v[e] * ALPHA_F + gt[e] * yv; }
            float s = 0.f;
#pragma unroll
            for (int e = 0; e < 4; ++e) s += v[e][0] + v[e][1] + v[e][2] + v[e][3];
            const float mu = wave_sum(s) * (1.0f / 1024.0f);
            float q = 0.f;
#pragma unroll
            for (int e = 0; e < 4; ++e)
#pragma unroll
                for (int i = 0; i < 4; ++i) { const float d = v[e][i] - mu; q += d * d; }
            const float rstd = rsqrtf(wave_sum(q) * (1.0f / 1024.0f) + LN_EPS_F);
#pragma unroll
            for (int e = 0; e < 4; ++e) { v[e] = (v[e] - mu) * rstd * lg[e] + lb[e]; __builtin_nontemporal_store(v[e], (f32x4*)(xb + lane * 4 + 256 * e)); }
        }
        if (layer < 4) {
#pragma unroll
            for (int e = 0; e < 4; ++e) { const int col = lane * 4 + 256 * e;
                const f32x4 h = v[e] * (sc[e] + 1.0f) + sh[e]; u32x2 o; o[0] = cvt_pk_bf16(h[0], h[1]); o[1] = cvt_pk_bf16(h[2], h[3]);
                *(u32x2*)(hog + (size_t)row * DM + col) = o; }
        }
    }
#undef LN_SRC
#undef LN_ROW
}
__device__ __forceinline__ void wconv_decode(const P& p, int layer, int t, const float*& W, int& N, bf16_t*& dst, int& kt, int& ntl, bool& isin) {
    isin = t < 1024;
    if (isin) { W = p.w_in + (size_t)layer * 1024 * 4096; N = 4096; dst = (bf16_t*)(p.ws + OFF_WTIN); kt = t >> 6; ntl = t & 63; }
    else { const int t2 = t - 1024; W = p.w_out + (size_t)layer * 1024 * 1024; N = 1024; dst = (bf16_t*)(p.ws + OFF_WTOUT); kt = t2 >> 4; ntl = t2 & 15; }
}
__device__ __forceinline__ void wconv_tiles(int TID, int rank, int nranks, int t_lo, int t_hi, const P& p, int layer, bool na, unsigned char* smem) {
    constexpr int NG = 5, TS = 64 * 65;
    float* tile = (float*)smem;
    const int tid = TID;
    for (int t0 = t_lo + rank; t0 < t_hi; t0 += NG * nranks) {
        f32x4 v[NG][2];
#pragma unroll
        for (int g = 0; g < NG; ++g) { const int t = t0 + g * nranks;
            if (t < t_hi) { const float* W; int N, kt, ntl; bf16_t* dst; bool isin; wconv_decode(p, layer, t, W, N, dst, kt, ntl, isin);
#pragma unroll
                for (int i = 0; i < 2; ++i) { const int idx = tid + i * 512, r = idx >> 4, c4 = idx & 15; v[g][i] = __builtin_nontemporal_load((const f32x4*)(W + (size_t)(kt * 64 + r) * N + ntl * 64 + c4 * 4)); } } }
#pragma unroll
        for (int g = 0; g < NG; ++g) { const int t = t0 + g * nranks;
            if (t < t_hi) {
#pragma unroll
                for (int i = 0; i < 2; ++i) { const int idx = tid + i * 512, r = idx >> 4, c4 = idx & 15;
#pragma unroll
                    for (int e = 0; e < 4; ++e) tile[g * TS + r * 65 + c4 * 4 + e] = v[g][i][e]; } } }
        __syncthreads();
#pragma unroll
        for (int g = 0; g < NG; ++g) { const int t = t0 + g * nranks;
            if (t < t_hi) { const float* W; int N, kt, ntl; bf16_t* dst; bool isin; wconv_decode(p, layer, t, W, N, dst, kt, ntl, isin);
                const int nl = tid >> 3, kg = tid & 7; int n = ntl * 64 + nl;
                if (na && isin) { if (n >= 3072) n -= 1024; else if (n >= 2048) n += 1024; }
                float f[8];
#pragma unroll
                for (int e = 0; e < 8; ++e) f[e] = tile[g * TS + (kg * 8 + e) * 65 + nl];
                u32x4 o; o[0] = cvt_pk_bf16(f[0], f[1]); o[1] = cvt_pk_bf16(f[2], f[3]); o[2] = cvt_pk_bf16(f[4], f[5]); o[3] = cvt_pk_bf16(f[6], f[7]);
                *(u32x4*)(dst + (size_t)n * 1024 + kt * 64 + kg * 8) = o; } }
        __syncthreads();
    }
}
__device__ __forceinline__ void filter_mlp(int TID, int BID, const P& p, unsigned char* smem) {
    float* zf = (float*)(smem + 57344); float* a1 = zf + 32 * 33; float* a2 = a1 + 32 * 65;
    float* wl1 = (float*)(smem + 81920); float* wl2 = wl1 + 33 * 64; float* wl3 = wl2 + 4096;
    const int tid = TID; int jcur = -1;
    float* a3g = (float*)(p.ws + OFF_A3);
    for (int it = (int)gridDim.x - 1 - BID; it < 272; it += gridDim.x) {
        const int j = it / 136, it2 = it % 136; const bool isctx = it2 >= 128; const int ptile = isctx ? it2 - 128 : it2, L = isctx ? 256 : 4096;
        if (j != jcur) { jcur = j;
            const f32x4* g1 = (const f32x4*)(p.f_w1 + (size_t)j * 33 * 64); const f32x4* g2 = (const f32x4*)(p.f_w2 + (size_t)j * 4096); const f32x4* g3 = (const f32x4*)(p.f_w3 + (size_t)j * 4096);
            for (int idx = tid; idx < 528 + 2048; idx += 512) { const f32x4 v = idx < 528 ? g1[idx] : (idx < 1552 ? g2[idx - 528] : g3[idx - 1552]); *(f32x4*)(wl1 + 4 * idx) = v; } }
        const float *w1 = p.f_w1 + (size_t)j * 33 * 64, *b1 = p.f_b1 + j * 64, *w2 = p.f_w2 + (size_t)j * 4096, *b2 = p.f_b2 + j * 64, *w3 = p.f_w3 + (size_t)j * 4096, *b3 = p.f_b3 + j * 64, *fq = p.f_freq + j * 192;
        for (int idx = tid; idx < 32 * 33; idx += 512) { const int pos = idx / 33, e = idx % 33, i = ptile * 32 + pos; float val;
            if (e == 0) val = (float)i / (float)(L - 1);
            else { const int band = (e - 1) & 15; const float f = 1e-4f + (float)band * ((15.0f - 1e-4f) / 15.0f); const float rev = f * (float)i / (float)L; val = e <= 16 ? cos_rev(rev) : -sin_rev(rev); }
            zf[idx] = val; }
        __syncthreads();
        const int pos = tid >> 4, o0 = tid & 15;
        { float acc[4];
#pragma unroll
          for (int r = 0; r < 4; ++r) acc[r] = b1[o0 + 16 * r];
#pragma unroll 11
          for (int e = 0; e < 33; ++e) { const float zv = zf[pos * 33 + e];
#pragma unroll
              for (int r = 0; r < 4; ++r) acc[r] += zv * wl1[e * 64 + o0 + 16 * r]; }
#pragma unroll
          for (int r = 0; r < 4; ++r) a1[pos * 65 + o0 + 16 * r] = fast_sin(fq[o0 + 16 * r] * acc[r]); }
        __syncthreads();
        { float acc[4];
#pragma unroll
          for (int r = 0; r < 4; ++r) acc[r] = b2[o0 + 16 * r];
#pragma unroll 8
          for (int e = 0; e < 64; ++e) { const float zv = a1[pos * 65 + e];
#pragma unroll
              for (int r = 0; r < 4; ++r) acc[r] += zv * wl2[e * 64 + o0 + 16 * r]; }
#pragma unroll
          for (int r = 0; r < 4; ++r) a2[pos * 65 + o0 + 16 * r] = fast_sin(fq[64 + o0 + 16 * r] * acc[r]); }
        __syncthreads();
        { float acc[4];
#pragma unroll
          for (int r = 0; r < 4; ++r) acc[r] = b3[o0 + 16 * r];
#pragma unroll 8
          for (int e = 0; e < 64; ++e) { const float zv = a2[pos * 65 + e];
#pragma unroll
              for (int r = 0; r < 4; ++r) acc[r] += zv * wl3[e * 64 + o0 + 16 * r]; }
          const int row = (isctx ? 4096 : 0) + ptile * 32 + pos;
#pragma unroll
          for (int r = 0; r < 4; ++r) a3g[((size_t)j * 4352 + row) * 64 + o0 + 16 * r] = fast_sin(fq[128 + o0 + 16 * r] * acc[r]); }
        __syncthreads();
    }
}
__device__ __forceinline__ void filter_taps(int TID, int rank, int nranks, const P& p, int j, bool with_ctx, unsigned char* smem) {
    const int tid = TID, lane = tid & 63, wid = tid >> 6;
    const int nunits = (128 + (with_ctx ? 8 : 0)) * 128, nw = nranks * 8;
    const float* w4 = p.f_w4 + (size_t)j * 64 * 4096; const float* a3g = (const float*)(p.ws + OFF_A3) + (size_t)j * 4352 * 64;
    float* circ_lat = (float*)(p.ws + OFF_CIRC_LAT); float* circ_ctx = (float*)(p.ws + OFF_CIRC_CTX);
    const int pc = lane & 31, kh = lane >> 5;
    const int u0 = nw - 1 - (rank * 8 + wid); const bool same_ct = (nw & 127) == 0;
    float aw[32], dl[16]; int ctl = -1;
    for (int u = u0; u < nunits; u += nw) {
        const int pt = u >> 7, ct = u & 127; const bool isctx = pt >= 128; const int ptile = isctx ? pt - 128 : pt, L = isctx ? 256 : 4096;
        const int i = ptile * 32 + pc; const float tpos = (float)i / (float)(L - 1);
        const float* arow = a3g + (size_t)((isctx ? 4096 : 0) + i) * 64 + kh * 32;
        float bq[32];
#pragma unroll
        for (int e = 0; e < 8; ++e) { const f32x4 v = *(const f32x4*)(arow + 4 * e); bq[4 * e] = v[0]; bq[4 * e + 1] = v[1]; bq[4 * e + 2] = v[2]; bq[4 * e + 3] = v[3]; }
        const int ch0 = ct * 32, wb = ch0 & 1023;
        if (!same_ct || ctl != ct) { ctl = ct;
            const float* wcol = w4 + (size_t)(kh * 32) * 4096 + ch0 + pc;
#pragma unroll
            for (int s = 0; s < 32; ++s) aw[s] = wcol[(size_t)s * 4096];
#pragma unroll
            for (int v = 0; v < 16; ++v) { const int w = wb + 8 * (v >> 2) + 4 * kh + (v & 3);
                dl[v] = fabsf(-3.0701134573253945f + (-15.350567286626973f + 3.0701134573253945f) * ((float)w * (1.0f / 1023.0f))); } }
        f32x16 acc;
#pragma unroll
        for (int v = 0; v < 16; ++v) acc[v] = 0.f;
#pragma unroll
        for (int s = 0; s < 32; ++s) acc = __builtin_amdgcn_mfma_f32_32x32x2f32(aw[s], bq[s], acc, 0, 0, 0);
        const int o = ch0 >> 11, d = (ch0 >> 10) & 1;
#pragma unroll
        for (int v = 0; v < 16; ++v) { const int w = wb + 8 * (v >> 2) + 4 * kh + (v & 3);
            const float val = acc[v] * __expf(-tpos * dl[v]);
            if (!(d == 1 && i == 0)) { if (!isctx) circ_lat[(size_t)(o * 1024 + w) * 8192 + (d ? 8192 - i : i)] = val; else circ_ctx[(size_t)(o * 1024 + w) * 512 + (d ? 512 - i : i)] = val; } }
    }
}

__device__ __forceinline__ int phys(int pp) { return ((pp & ~15) | ((pp ^ (pp >> 4)) & 15)) + ((pp >> 8) << 4); }
__device__ __forceinline__ constexpr int brev(int x, int bits) { int r = 0; for (int i = 0; i < bits; ++i) r |= ((x >> i) & 1) << (bits - 1 - i); return r; }
__device__ __forceinline__ constexpr float tw_c(int i) {
    constexpr float T[16] = {1.0f, 0.98078528040323043f, 0.92387953251128674f, 0.83146961230254524f, 0.70710678118654757f, 0.55557023301960229f, 0.38268343236508984f, 0.19509032201612833f,
                             0.0f, -0.19509032201612833f, -0.38268343236508984f, -0.55557023301960229f, -0.70710678118654757f, -0.83146961230254524f, -0.92387953251128674f, -0.98078528040323043f};
    return T[i];
}
__device__ __forceinline__ constexpr float tw_s(int i) {
    constexpr float T[16] = {0.0f, 0.19509032201612825f, 0.38268343236508978f, 0.55557023301960218f, 0.70710678118654746f, 0.83146961230254524f, 0.92387953251128674f, 0.98078528040323043f,
                             1.0f, 0.98078528040323043f, 0.92387953251128674f, 0.83146961230254546f, 0.70710678118654757f, 0.55557023301960218f, 0.38268343236508989f, 0.19509032201612861f};
    return T[i];
}
__device__ __forceinline__ f32x2 mk2(float x, float y) { f32x2 r; r.x = x; r.y = y; return r; }
__device__ __forceinline__ f32x2 cswap(f32x2 v) { return __builtin_shufflevector(v, v, 1, 0); }
__device__ __forceinline__ f32x2 cmul_fwd(f32x2 v, float c, float s) { return v * c + cswap(v) * mk2(s, -s); }
__device__ __forceinline__ f32x2 cmul_inv(f32x2 v, float c, float s) { return v * c + cswap(v) * mk2(-s, s); }
__device__ __forceinline__ f32x2 mul_mi(f32x2 v) { return mk2(v.y, -v.x); }
__device__ __forceinline__ f32x2 mul_pi(f32x2 v) { return mk2(-v.y, v.x); }
template <int R, int S> __device__ __forceinline__ void dif_stage(f32x2 (&a)[R]) {
#pragma unroll
    for (int b = 0; b < R; b += 2 * S)
#pragma unroll
        for (int jj = 0; jj < S; ++jj) { const int i0 = b + jj, i1 = i0 + S, ti = jj * (16 / S);
            const f32x2 u = a[i0], v = a[i1]; a[i0] = u + v; const f32x2 d = u - v;
            if (ti == 0) a[i1] = d; else if (ti == 8) a[i1] = mul_mi(d); else a[i1] = cmul_fwd(d, tw_c(ti), tw_s(ti)); }
}
template <int R, int S> __device__ __forceinline__ void dit_stage(f32x2 (&a)[R]) {
#pragma unroll
    for (int b = 0; b < R; b += 2 * S)
#pragma unroll
        for (int jj = 0; jj < S; ++jj) { const int i0 = b + jj, i1 = i0 + S, ti = jj * (16 / S);
            const f32x2 u = a[i0], x = a[i1]; f32x2 v;
            if (ti == 0) v = x; else if (ti == 8) v = mul_pi(x); else v = cmul_inv(x, tw_c(ti), tw_s(ti));
            a[i0] = u + v; a[i1] = u - v; }
}
__device__ __forceinline__ void dif16(f32x2 (&a)[16]) { dif_stage<16, 8>(a); dif_stage<16, 4>(a); dif_stage<16, 2>(a); dif_stage<16, 1>(a); }
__device__ __forceinline__ void dit16(f32x2 (&a)[16]) { dit_stage<16, 1>(a); dit_stage<16, 2>(a); dit_stage<16, 4>(a); dit_stage<16, 8>(a); }

struct TwPow { float c1, s1, c2, s2, c4, s4, c8, s8, c16, s16; };
__device__ __forceinline__ TwPow make_tw(float rev) {
    TwPow t; t.c1 = cos_rev(rev); t.s1 = sin_rev(rev);
    t.c2 = t.c1 * t.c1 - t.s1 * t.s1; t.s2 = 2.0f * t.c1 * t.s1; t.c4 = t.c2 * t.c2 - t.s2 * t.s2; t.s4 = 2.0f * t.c2 * t.s2;
    t.c8 = t.c4 * t.c4 - t.s4 * t.s4; t.s8 = 2.0f * t.c4 * t.s4; t.c16 = t.c8 * t.c8 - t.s8 * t.s8; t.s16 = 2.0f * t.c8 * t.s8; return t;
}
__device__ __forceinline__ void tw_opaque(TwPow& t) { asm volatile("" : "+v"(t.c1), "+v"(t.s1), "+v"(t.c2), "+v"(t.s2), "+v"(t.c4), "+v"(t.s4), "+v"(t.c8), "+v"(t.s8), "+v"(t.c16), "+v"(t.s16)); }
#define TW_ACC(bit, cc, ss) if (m & bit) { if (!have) { c = cc; s = ss; have = true; } else { const float nc = c * cc - s * ss; s = c * ss + s * cc; c = nc; } }
__device__ __forceinline__ void tw_get_lo_first(const TwPow& t, int m, float& c, float& s) {
    bool have = false; c = 1.f; s = 0.f; TW_ACC(1, t.c1, t.s1) TW_ACC(2, t.c2, t.s2) TW_ACC(4, t.c4, t.s4) TW_ACC(8, t.c8, t.s8) TW_ACC(16, t.c16, t.s16)
}
__device__ __forceinline__ void tw_get_hi_first(const TwPow& t, int m, float& c, float& s) {
    bool have = false; c = 1.f; s = 0.f; TW_ACC(16, t.c16, t.s16) TW_ACC(8, t.c8, t.s8) TW_ACC(4, t.c4, t.s4) TW_ACC(2, t.c2, t.s2) TW_ACC(1, t.c1, t.s1)
}
__device__ __forceinline__ void tw_get_p1(const TwPow& t, int m, float& c, float& s) {
    bool have = false; c = 1.f; s = 0.f; TW_ACC(2, t.c2, t.s2) TW_ACC(4, t.c4, t.s4) TW_ACC(8, t.c8, t.s8) TW_ACC(16, t.c16, t.s16) TW_ACC(1, t.c1, t.s1)
}
#undef TW_ACC

template <bool FULL> __device__ __forceinline__ void fft_p1(f32x2* buf, int j) {
    asm volatile("" : "+v"(j));
    f32x2* bj = buf + phys(j);
    f32x2 a[16], d[16];
#pragma unroll
    for (int k = 0; k < 16; ++k) a[k] = bj[272 * k];
    if (FULL) {
#pragma unroll
        for (int k = 0; k < 16; ++k) { const f32x2 v = bj[272 * (k + 16)]; d[k] = a[k] - v; a[k] = a[k] + v; }
    } else {
#pragma unroll
        for (int k = 0; k < 16; ++k) d[k] = a[k];
    }
    TwPow tw = make_tw((float)j * (1.0f / 8192.0f));
    dif16(a);
#pragma unroll
    for (int i = 0; i < 16; ++i) { const int m = 2 * brev(i, 4); f32x2 x = a[i]; if (m != 0) { float c, sn; tw_get_p1(tw, m, c, sn); x = cmul_fwd(x, c, sn); } bj[272 * m] = x; }
    tw_opaque(tw);
#pragma unroll
    for (int k = 1; k < 16; ++k) { if (k == 8) d[k] = mul_mi(d[k]); else d[k] = cmul_fwd(d[k], tw_c(k), tw_s(k)); }
    dif16(d);
#pragma unroll
    for (int i = 0; i < 16; ++i) { const int m = 2 * brev(i, 4) + 1; float c, sn; tw_get_p1(tw, m, c, sn); bj[272 * m] = cmul_fwd(d[i], c, sn); }
}
__device__ __forceinline__ void fft_p2(f32x2* buf, int j) {
    asm volatile("" : "+v"(j));
#pragma unroll
    for (int i = 0; i < 2; ++i) { const int q = j + 256 * i, base = (q >> 4) * 256 + (q & 15), jj = q & 15;
        f32x2 a[16];
#pragma unroll
        for (int k = 0; k < 16; ++k) a[k] = buf[phys(base + 16 * k)];
        const TwPow tw = make_tw((float)jj * (1.0f / 256.0f));
        dif16(a);
#pragma unroll
        for (int idx = 0; idx < 16; ++idx) { const int m = brev(idx, 4); f32x2 x = a[idx];
            if (m != 0) { float c, sn; tw_get_lo_first(tw, m, c, sn); x = cmul_fwd(x, c, sn); }
            buf[phys(base + 16 * m)] = x; } }
}
__device__ __forceinline__ void fft_p3_mul_ia(f32x2* buf, int j, const u32x4 (&hpre)[8]) {
    asm volatile("" : "+v"(j));
#pragma unroll
    for (int i = 0; i < 2; ++i) { const int q = j + 256 * i;
        u32x4 hr[4];
#pragma unroll
        for (int e = 0; e < 4; ++e) hr[e] = hpre[4 * i + e];
        f32x2 a[16];
#pragma unroll
        for (int k = 0; k < 16; ++k) a[k] = buf[phys(16 * q + k)];
        dif16(a);
#pragma unroll
        for (int idx = 0; idx < 16; ++idx) { const int m = brev(idx, 4); const unsigned hu = hr[m >> 2][m & 3];
            const float hx = __half2float(__ushort_as_half((unsigned short)(hu & 0xffffu))), hy = __half2float(__ushort_as_half((unsigned short)(hu >> 16)));
            a[idx] = a[idx] * hx + cswap(a[idx]) * mk2(-hy, hy); }
        dit16(a);
#pragma unroll
        for (int k = 0; k < 16; ++k) buf[phys(16 * q + k)] = a[k]; }
}
__device__ __forceinline__ void fft_ib(f32x2* buf, int j) {
    asm volatile("" : "+v"(j));
#pragma unroll
    for (int i = 0; i < 2; ++i) { const int q = j + 256 * i, base = (q >> 4) * 256 + (q & 15), jj = q & 15;
        f32x2 a[16];
        const TwPow tw = make_tw((float)jj * (1.0f / 256.0f));
#pragma unroll
        for (int m = 0; m < 16; ++m) { const int idx = brev(m, 4); f32x2 x = buf[phys(base + 16 * m)];
            if (m != 0) { float c, sn; tw_get_hi_first(tw, m, c, sn); x = cmul_inv(x, c, sn); }
            a[idx] = x; }
        dit16(a);
#pragma unroll
        for (int k = 0; k < 16; ++k) buf[phys(base + 16 * k)] = a[k]; }
}
__device__ __forceinline__ void fft_ic(f32x2* buf, int j) {
    asm volatile("" : "+v"(j));
    f32x2* bj = buf + phys(j);
    f32x2 u[16], v[16];
    TwPow tw = make_tw((float)j * (1.0f / 8192.0f));
#pragma unroll
    for (int mm = 0; mm < 16; ++mm) { const int idx = brev(mm, 4), m = 2 * mm; f32x2 x = bj[272 * m]; if (m != 0) { float c, sn; tw_get_hi_first(tw, m, c, sn); x = cmul_inv(x, c, sn); } u[idx] = x; }
    dit16(u);
    tw_opaque(tw);
#pragma unroll
    for (int mm = 0; mm < 16; ++mm) { const int idx = brev(mm, 4), m = 2 * mm + 1; float c, sn; tw_get_hi_first(tw, m, c, sn); v[idx] = cmul_inv(bj[272 * m], c, sn); }
    dit16(v);
#pragma unroll
    for (int k = 0; k < 16; ++k) { f32x2 x = v[k];
        if (k == 8) x = mul_pi(x); else if (k != 0) x = cmul_inv(x, tw_c(k), tw_s(k));
        bj[272 * k] = u[k] + x; }
}
__device__ __forceinline__ void conv_core(f32x2* buf, int j, const unsigned* H) {
    fft_p1<false>(buf, j); __syncthreads();
    u32x4 hpre[8];
#pragma unroll
    for (int e = 0; e < 4; ++e) { hpre[e] = *(const u32x4*)(H + 16 * j + 4 * e); hpre[4 + e] = *(const u32x4*)(H + 16 * (j + 256) + 4 * e); }
    fft_p2(buf, j); __syncthreads();
    fft_p3_mul_ia(buf, j, hpre); __syncthreads();
    fft_ib(buf, j); __syncthreads();
    fft_ic(buf, j); __syncthreads();
}

#if DEBUG_CHECK & 1
__device__ __forceinline__ float dbg_hash(unsigned x) { x ^= x >> 16; x *= 0x7feb352du; x ^= x >> 15; x *= 0x846ca68bu; x ^= x >> 16; return (float)(x & 0xffffff) * (1.0f / 8388608.0f) - 1.0f; }
__device__ __forceinline__ void dbg_fft_test(int TID, const P& p, unsigned char* smem) {
    const int tid = TID, grp = tid >> 8, j = tid & 255;
    f32x2* buf = (f32x2*)(smem + grp * FFT_BYTES);
    unsigned* Hd = (unsigned*)(p.ws + OFF_HLAT) + (size_t)grp * 8192;
#pragma unroll
    for (int k = 0; k < 16; ++k) { buf[phys(16 * j + k)] = mk2(dbg_hash(16 * j + k + 12345) * (1.0f / 8192.0f), 0.f); buf[phys(4096 + 16 * j + k)] = mk2(dbg_hash(4096 + 16 * j + k + 12345) * (1.0f / 8192.0f), 0.f); }
    __syncthreads();
    fft_p1<true>(buf, j); __syncthreads();
    fft_p2(buf, j); __syncthreads();
#pragma unroll 1
    for (int i = 0; i < 2; ++i) { const int q = j + 256 * i; f32x2 a[16];
#pragma unroll
        for (int k = 0; k < 16; ++k) a[k] = buf[phys(16 * q + k)];
        dif16(a);
#pragma unroll
        for (int idx = 0; idx < 16; ++idx) { const int m = brev(idx, 4); Hd[16 * q + m] = (unsigned)__half_as_ushort(__float2half_rn(a[idx].x)) | ((unsigned)__half_as_ushort(__float2half_rn(a[idx].y)) << 16); } }
    __threadfence(); __syncthreads();
#pragma unroll
    for (int k = 0; k < 16; ++k) buf[phys(16 * j + k)] = mk2(dbg_hash(16 * j + k + 777), dbg_hash(16 * j + k + 99991));
    __syncthreads();
    conv_core(buf, j, Hd);
    const int t = 16 * j + 3; const f32x2 y = buf[phys(t)];
    float er = 0.f, ei = 0.f;
    for (int s2 = 0; s2 < 4096; ++s2) { const float kk = dbg_hash(((t - s2) & 8191) + 12345) * (1.0f / 8192.0f); er += kk * dbg_hash(s2 + 777); ei += kk * dbg_hash(s2 + 99991); }
    float dev = fmaxf(fabsf(y.x * (1.0f / 8192.0f) - er), fabsf(y.y * (1.0f / 8192.0f) - ei)) * (1.0f / 0.0026f);
#pragma unroll
    for (int o = 32; o; o >>= 1) dev = fmaxf(dev, __shfl_xor(dev, o, 64));
    if ((tid & 63) == 0) atomicMax((unsigned*)(p.ws + WS_END + 4), __float_as_uint(dev));
    __syncthreads();
}
#endif
__device__ __forceinline__ void f2_load(const float* circ_lat, const float* circ_ctx, bool active, bool isctx, int ow, int j, float (&lo)[16], float (&hi)[16]) {
#pragma unroll
    for (int k = 0; k < 16; ++k) { lo[k] = 0.f; hi[k] = 0.f; }
    if (active) {
        if (!isctx) { const float* src = circ_lat + (size_t)ow * 8192;
#pragma unroll
            for (int e = 0; e < 4; ++e) { const f32x4 a = __builtin_nontemporal_load((const f32x4*)(src + 16 * j + 4 * e)), b = __builtin_nontemporal_load((const f32x4*)(src + 4096 + 16 * j + 4 * e));
#pragma unroll
                for (int i = 0; i < 4; ++i) { lo[4 * e + i] = a[i]; hi[4 * e + i] = b[i]; } }
            if (j == 0) hi[0] = 0.f;
        } else { const float* src = circ_ctx + (size_t)ow * 512;
            if (j < 16) {
#pragma unroll
                for (int e = 0; e < 4; ++e) { const f32x4 a = *(const f32x4*)(src + 16 * j + 4 * e);
#pragma unroll
                    for (int i = 0; i < 4; ++i) lo[4 * e + i] = a[i]; } }
            if (j >= 240) {
#pragma unroll
                for (int e = 0; e < 4; ++e) { const f32x4 b = *(const f32x4*)(src + 16 * j - 3584 + 4 * e);
#pragma unroll
                    for (int i = 0; i < 4; ++i) hi[4 * e + i] = b[i]; }
                if (j == 240) hi[0] = 0.f; }
        }
    }
}
__device__ __forceinline__ void phase_f2(int TID, int BID, const P& p, bool with_ctx, unsigned char* smem) {
    const int tid = TID, grp = tid >> 8, j = tid & 255, lane = tid & 63, wg = (tid >> 6) & 3;
    f32x2* buf = (f32x2*)(smem + grp * FFT_BYTES); float* red = (float*)(smem + 2 * FFT_BYTES) + grp * 8;
    const int nitems = with_ctx ? 2048 : 1024, nrounds = (nitems + 2 * (int)gridDim.x - 1) / (2 * (int)gridDim.x);
    const float* circ_lat = (const float*)(p.ws + OFF_CIRC_LAT); const float* circ_ctx = (const float*)(p.ws + OFF_CIRC_CTX);
    for (int rd = 0; rd < nrounds; ++rd) {
        const int item = (rd * (int)gridDim.x + BID) * 2 + grp; const bool active = item < nitems, isctx = item >= 1024; const int w = item & 1023;
        { float lo[16], hi[16], lo1[16], hi1[16]; float s0 = 0.f, s1 = 0.f;
          f2_load(circ_lat, circ_ctx, active, isctx, w, j, lo, hi);
          f2_load(circ_lat, circ_ctx, active, isctx, 1024 + w, j, lo1, hi1);
#pragma unroll
          for (int k = 0; k < 16; ++k) { s0 += fabsf(lo[k]) + fabsf(hi[k]); s1 += fabsf(lo1[k]) + fabsf(hi1[k]); }
#pragma unroll
          for (int k = 0; k < 16; ++k) { buf[phys(16 * j + k)] = mk2(lo[k], lo1[k]); buf[phys(4096 + 16 * j + k)] = mk2(hi[k], hi1[k]); }
          s0 = wave_sum(s0); s1 = wave_sum(s1);
          if (lane == 0) { red[wg] = s0; red[4 + wg] = s1; } }
        __syncthreads();
        const float inv0 = 0.5f / (red[0] + red[1] + red[2] + red[3]), inv1 = 0.5f / (red[4] + red[5] + red[6] + red[7]);
        fft_p1<true>(buf, j); __syncthreads();
        fft_p2(buf, j); __syncthreads();
#pragma unroll 1
        for (int i = 0; i < 2; ++i) { const int q = j + 256 * i;
            f32x2 a[16];
#pragma unroll
            for (int k = 0; k < 16; ++k) a[k] = buf[phys(16 * q + k)];
            dif16(a);
#pragma unroll
            for (int idx = 0; idx < 16; ++idx) { const int m = brev(idx, 4); buf[phys(16 * q + m)] = a[idx]; } }
        __syncthreads();
        unsigned* Hd0 = (unsigned*)(p.ws + (isctx ? OFF_HCTX : OFF_HLAT)) + (size_t)w * 8192; unsigned* Hd1 = Hd0 + (size_t)1024 * 8192;
#pragma unroll 1
        for (int i = 0; i < 2; ++i) { const int q = j + 256 * i;
            unsigned h0[16], h1[16];
#pragma unroll
            for (int m = 0; m < 16; ++m) { const int pp = 16 * q + m;
                const int f = (pp >> 8) + 32 * ((pp >> 4) & 15) + 512 * (pp & 15), fn = (8192 - f) & 8191, pn = ((fn & 31) << 8) | (((fn >> 5) & 15) << 4) | (fn >> 9);
                const f32x2 g = buf[phys(pp)], gn = buf[phys(pn)];
                const float ar = (g.x + gn.x) * inv0, ai = (g.y - gn.y) * inv0, br = (g.y + gn.y) * inv1, bi = (gn.x - g.x) * inv1;
                h0[m] = (unsigned)__half_as_ushort(__float2half_rn(ar)) | ((unsigned)__half_as_ushort(__float2half_rn(ai)) << 16);
                h1[m] = (unsigned)__half_as_ushort(__float2half_rn(br)) | ((unsigned)__half_as_ushort(__float2half_rn(bi)) << 16); }
            if (active) {
#pragma unroll
                for (int e = 0; e < 4; ++e) { u32x4 o; o[0] = h0[4 * e]; o[1] = h0[4 * e + 1]; o[2] = h0[4 * e + 2]; o[3] = h0[4 * e + 3]; *(u32x4*)(Hd0 + 16 * q + 4 * e) = o;
                    u32x4 o1; o1[0] = h1[4 * e]; o1[1] = h1[4 * e + 1]; o1[2] = h1[4 * e + 2]; o1[3] = h1[4 * e + 3]; *(u32x4*)(Hd1 + 16 * q + 4 * e) = o1; } } }
        __syncthreads();
#if DEBUG_CHECK & 8
        if (active && (rd == nrounds - 1 || rd == 0)) {
            __threadfence(); __syncthreads();
            unsigned x = (unsigned)(BID * 512 + tid) * 2654435761u + 777u + rd; x ^= x >> 16; x *= 0x7feb352du; x ^= x >> 15;
            const int f = (int)(x & 8191u), o = (int)((x >> 13) & 1u);
            float sr = 0.f, si = 0.f, nrm = 0.f;
            for (int pp = 0; pp < 8192; ++pp) { float tv;
                if (!isctx) tv = (pp == 4096) ? 0.f : circ_lat[(size_t)(o * 1024 + w) * 8192 + pp];
                else tv = (pp < 256) ? circ_ctx[(size_t)(o * 1024 + w) * 512 + pp] : ((pp > 7936) ? circ_ctx[(size_t)(o * 1024 + w) * 512 + pp - 7680] : 0.f);
                nrm += fabsf(tv); const float rev = (float)((f * pp) & 8191) * (1.0f / 8192.0f); sr += tv * cospif(2.0f * rev); si -= tv * sinpif(2.0f * rev); }
            const int pos = ((f & 31) << 8) | (((f >> 5) & 15) << 4) | (f >> 9);
            const unsigned hu = ((const unsigned*)(p.ws + (isctx ? OFF_HCTX : OFF_HLAT)))[(size_t)(o * 1024 + w) * 8192 + pos];
            const float hx = __half2float(__ushort_as_half((unsigned short)(hu & 0xffffu))), hy = __half2float(__ushort_as_half((unsigned short)(hu >> 16)));
            float dev = (fabsf(hx - sr / nrm) + fabsf(hy - si / nrm)) * 50.0f;
#pragma unroll
            for (int oo = 32; oo; oo >>= 1) dev = fmaxf(dev, __shfl_xor(dev, oo, 64));
            if ((tid & 63) == 0) atomicMax((unsigned*)(p.ws + WS_END), __float_as_uint(dev));
            __syncthreads();
        }
#endif
    }
}

__device__ __forceinline__ void load_row16(const bf16_t* seq, int t0, int L, bool valid, float (&v)[18]) {
    if (valid) { const u32x4 a = __builtin_nontemporal_load((const u32x4*)(seq + t0)), b = __builtin_nontemporal_load((const u32x4*)(seq + t0 + 8));
#pragma unroll
        for (int e = 0; e < 4; ++e) { v[1 + 2 * e] = bflo(a[e]); v[2 + 2 * e] = bfhi(a[e]); v[9 + 2 * e] = bflo(b[e]); v[10 + 2 * e] = bfhi(b[e]); }
        v[0] = t0 > 0 ? bf2f(seq[t0 - 1]) : 0.f; v[17] = (t0 + 16 < L) ? bf2f(seq[t0 + 16]) : 0.f;
    } else {
#pragma unroll
        for (int k = 0; k < 18; ++k) v[k] = 0.f; }
}
__device__ __forceinline__ void short_conv16(const bf16_t* seq, int t0, int L, bool valid, float w0, float w1, float w2, float bias, float (&o)[16]) {
    float v[18]; load_row16(seq, t0, L, valid, v);
#pragma unroll
    for (int k = 0; k < 16; ++k) o[k] = valid ? (w0 * v[k] + w1 * v[k + 1] + w2 * v[k + 2] + bias) : 0.f;
}
__device__ __forceinline__ void phase_conv(int TID, int BID, const P& p, int jh, bool with_ctx, unsigned char* smem) {
    const int tid = TID, grp = tid >> 8, j = tid & 255;
    f32x2* buf = (f32x2*)(smem + grp * FFT_BYTES);
    const int nitems = 4096 + (with_ctx ? 1024 : 0), nrounds = (nitems + 2 * (int)gridDim.x - 1) / (2 * (int)gridDim.x);
    bf16_t* projT = (bf16_t*)(p.ws + OFF_QKVZ);
    const float* cw = p.hy_conv_w + (size_t)jh * 3 * 3072; const float* cb = p.hy_conv_b + (size_t)jh * 3072; const float* skip = p.hy_skip + (size_t)jh * 2 * 1024;
    for (int rd = 0; rd < nrounds; ++rd) {
        const int item = (rd * (int)gridDim.x + BID) * 2 + grp; const bool active = item < nitems, isctx = item >= 4096;
        int c, t0, L, offRe, offIm; bool vRe, vIm;
        if (!isctx) { c = item >> 2; const int pair = item & 3; t0 = 16 * j; L = 4096; offRe = (2 * pair) * 4096; offIm = offRe + 4096; vRe = active; vIm = active; }
        else { c = item - 4096; t0 = 16 * (j & 31); L = 256; offRe = NLAT + (j >> 5) * 256; offIm = offRe; vRe = active && ((j & 31) < 16); vIm = false; }
        if (!active) c = 0;
        const bf16_t* rv = projT + (size_t)c * LDT; const bf16_t* rx1 = projT + (size_t)(1024 + c) * LDT; const bf16_t* rx2 = projT + (size_t)(2048 + c) * LDT; bf16_t* rg = projT + (size_t)(3072 + c) * LDT;
        const unsigned* H0 = (const unsigned*)(p.ws + (isctx ? OFF_HCTX : OFF_HLAT)) + (size_t)c * 8192; const unsigned* H1 = H0 + (size_t)1024 * 8192;
        float zr[16], zi[16];
        short_conv16(rv + offRe, t0, L, vRe, cw[c], cw[3072 + c], cw[6144 + c], cb[c], zr);
        short_conv16(rv + offIm, t0, L, vIm, cw[c], cw[3072 + c], cw[6144 + c], cb[c], zi);
#pragma unroll
        for (int k = 0; k < 16; ++k) buf[phys(16 * j + k)] = mk2(zr[k], zi[k]);
        __syncthreads();
        conv_core(buf, j, H0);
        { float xr[16], xi[16]; const float sk = skip[c];
          short_conv16(rx1 + offRe, t0, L, vRe, cw[1024 + c], cw[3072 + 1024 + c], cw[6144 + 1024 + c], cb[1024 + c], xr);
          short_conv16(rx1 + offIm, t0, L, vIm, cw[1024 + c], cw[3072 + 1024 + c], cw[6144 + 1024 + c], cb[1024 + c], xi);
#pragma unroll
          for (int k = 0; k < 16; ++k) { const f32x2 y = buf[phys(16 * j + k)];
              zr[k] = xr[k] * (y.x * (1.0f / 8192.0f) + zr[k] * sk); zi[k] = xi[k] * (y.y * (1.0f / 8192.0f) + zi[k] * sk);
              buf[phys(16 * j + k)] = mk2(zr[k], zi[k]); } }
        __syncthreads();
        conv_core(buf, j, H1);
        { float xr[16], xi[16]; const float sk = skip[1024 + c];
          short_conv16(rx2 + offRe, t0, L, vRe, cw[2048 + c], cw[3072 + 2048 + c], cw[6144 + 2048 + c], cb[2048 + c], xr);
          short_conv16(rx2 + offIm, t0, L, vIm, cw[2048 + c], cw[3072 + 2048 + c], cw[6144 + 2048 + c], cb[2048 + c], xi);
#pragma unroll
          for (int k = 0; k < 16; ++k) { const f32x2 y = buf[phys(16 * j + k)];
              zr[k] = xr[k] * (y.x * (1.0f / 8192.0f) + zr[k] * sk); zi[k] = xi[k] * (y.y * (1.0f / 8192.0f) + zi[k] * sk); } }
        if (vRe) { bf16_t* gp = rg + offRe + t0; const u32x4 a = __builtin_nontemporal_load((const u32x4*)gp), b = __builtin_nontemporal_load((const u32x4*)(gp + 8)); u32x4 oa, ob;
#pragma unroll
            for (int e = 0; e < 4; ++e) { oa[e] = cvt_pk_bf16(zr[2 * e] * silu_f(bflo(a[e])), zr[2 * e + 1] * silu_f(bfhi(a[e]))); ob[e] = cvt_pk_bf16(zr[8 + 2 * e] * silu_f(bflo(b[e])), zr[9 + 2 * e] * silu_f(bfhi(b[e]))); }
            *(u32x4*)gp = oa; *(u32x4*)(gp + 8) = ob; }
        if (vIm) { bf16_t* gp = rg + offIm + t0; const u32x4 a = __builtin_nontemporal_load((const u32x4*)gp), b = __builtin_nontemporal_load((const u32x4*)(gp + 8)); u32x4 oa, ob;
#pragma unroll
            for (int e = 0; e < 4; ++e) { oa[e] = cvt_pk_bf16(zi[2 * e] * silu_f(bflo(a[e])), zi[2 * e + 1] * silu_f(bfhi(a[e]))); ob[e] = cvt_pk_bf16(zi[8 + 2 * e] * silu_f(bflo(b[e])), zi[9 + 2 * e] * silu_f(bfhi(b[e]))); }
            *(u32x4*)gp = oa; *(u32x4*)(gp + 8) = ob; }
    }
}

__device__ __forceinline__ void phase_transpose(int TID, int BID, const P& p, int ntok, unsigned char* smem) {
    bf16_t* tile = (bf16_t*)smem;
    const int tid = TID; const bf16_t* src = (const bf16_t*)(p.ws + OFF_QKVZ) + (size_t)3072 * LDT; bf16_t* og = (bf16_t*)(p.ws + OFF_HOG);
    const int ntt = ntok / 256, ngroups = 16 * ntt;
    for (int t = BID; t < ngroups; t += gridDim.x) { const int ct = t / ntt, tt = t % ntt;
        { const int r = tid >> 3, ch = tid & 7; u32x4 v[4];
#pragma unroll
          for (int q = 0; q < 4; ++q) v[q] = __builtin_nontemporal_load((const u32x4*)(src + (size_t)(ct * 64 + r) * LDT + tt * 256 + q * 64 + ch * 8));
#pragma unroll
          for (int q = 0; q < 4; ++q) *(u32x4*)(tile + q * 4608 + r * 72 + ch * 8) = v[q]; }
        __syncthreads();
        { const int tk = tid >> 3, cg8 = tid & 7;
#pragma unroll
          for (int q = 0; q < 4; ++q) { unsigned short e[8];
#pragma unroll
              for (int i = 0; i < 8; ++i) e[i] = tile[q * 4608 + (cg8 * 8 + i) * 72 + tk];
              u32x4 o; o[0] = e[0] | ((unsigned)e[1] << 16); o[1] = e[2] | ((unsigned)e[3] << 16); o[2] = e[4] | ((unsigned)e[5] << 16); o[3] = e[6] | ((unsigned)e[7] << 16);
              *(u32x4*)(og + (size_t)(tt * 256 + q * 64 + tk) * DM + ct * 64 + cg8 * 8) = o; } }
        __syncthreads();
    }
}

__device__ __forceinline__ void att_load_k(int TID, const bf16_t* __restrict__ qkz, bool lat, int b, int h, int rp, u32x4 (&kreg)[13]) {
    const int R0 = min(min(max(2 * rp - 4, 0), 56), 55), tokL = b * 4096 + R0 * 64, ctx0 = NLAT + b * 256;
    const int toff = (TID >> 3) * 3072 + (TID & 7) * 8;
    const bf16_t* lbase = qkz + (size_t)tokL * 3072 + 1024 + h * 64; const bf16_t* cbase = qkz + (size_t)ctx0 * 3072 + 1024 + h * 64;
    if (lat) {
#pragma unroll
        for (int i = 0; i < 9; ++i) kreg[i] = *(const u32x4*)(lbase + (size_t)(64 * i) * 3072 + toff); }
#pragma unroll
    for (int i = 9; i < 13; ++i) kreg[i] = *(const u32x4*)(cbase + (size_t)(64 * (i - 9)) * 3072 + toff);
}
template <bool LAT>
__device__ __forceinline__ void att_item(int TID, const bf16_t* __restrict__ qkz, const bf16_t* __restrict__ vt, bf16_t* __restrict__ og, unsigned char* smem, const float* __restrict__ rpb_g, int b, int h, int rp,
                                         u32x4 (&kreg)[13], bool has_next, bool nlat, int nb, int nh, int nrp) {
    constexpr int NT = LAT ? 32 : 16, KSTR = 160, VSTR = 1680;
    const int tid = TID, lane = tid & 63, wid = tid >> 6, c = lane & 15, g = lane >> 4;
    float* rpb = (float*)(smem + 133632);
    int r = 0, n = 0, qtok0, r0 = 0, R0 = 0;
    if (LAT) { r = 2 * rp + (wid >> 2); n = wid & 3; qtok0 = b * 4096 + r * 64 + 16 * n; r0 = min(max(r - 4, 0), 56); R0 = min(min(max(2 * rp - 4, 0), 56), 55); }
    else qtok0 = NLAT + b * 256 + 16 * (8 * rp + wid);
    const int tokL = b * 4096 + R0 * 64, ctx0 = NLAT + b * 256, bs = min(max(16 * n - 8, 0), 32), rowoff = (r0 - R0) * 64;
    const bf16_t* qrow = qkz + (size_t)(qtok0 + c) * 3072 + h * 64 + 8 * g;
    const bf16x8 q0 = *(const bf16x8*)qrow, q1 = *(const bf16x8*)(qrow + 32);
    __syncthreads();
    { unsigned char* kw = smem + (tid >> 3) * KSTR + (tid & 7) * 16;
#pragma unroll
      for (int i = (LAT ? 0 : 9); i < 13; ++i) *(u32x4*)(kw + 64 * i * KSTR) = kreg[i]; }
    if (LAT && tid < 465) rpb[(tid / 31) * 64 + (tid % 31) + 16] = rpb_g[tid];
    __syncthreads();
    f32x4 S[NT];
#pragma unroll
    for (int T = 0; T < NT; ++T) {
        const int tl0 = (LAT && T < 16) ? rowoff + (T >> 1) * 64 + bs + (T & 1) * 16 : 576 + 16 * (T - (LAT ? 16 : 0));
        const unsigned char* kp = smem + (tl0 + c) * KSTR + g * 16;
        const bf16x8 k0 = *(const bf16x8*)kp, k1 = *(const bf16x8*)(kp + 64);
        f32x4 a = (f32x4){0.f, 0.f, 0.f, 0.f};
        a = __builtin_amdgcn_mfma_f32_16x16x32_bf16(k0, q0, a, 0, 0, 0);
        a = __builtin_amdgcn_mfma_f32_16x16x32_bf16(k1, q1, a, 0, 0, 0);
        S[T] = a;
    }
    u32x4 vreg[13];
    const bf16_t* vgl = vt + (size_t)(h * 64 + (tid >> 3)) * LDT + tokL + (tid & 7) * 8; const bf16_t* vgc = vt + (size_t)(h * 64 + (tid >> 3)) * LDT + ctx0 + (tid & 7) * 8;
    bool okm[2][4]; const float* bl = rpb;
    if (LAT) { const int cq = 16 * n + c, qs = min(max(cq - 8, 0), 48); bl = rpb + (r0 - r + 7) * 64 + (bs + 4 * g - cq + 31);
#pragma unroll
        for (int hh = 0; hh < 2; ++hh)
#pragma unroll
            for (int jj = 0; jj < 4; ++jj) okm[hh][jj] = (unsigned)(bs + 16 * hh + 4 * g + jj - qs) < 16u; }
    float mx = -3.0e38f;
#pragma unroll
    for (int T = 0; T < NT; ++T) {
        if (LAT && T < 16) { const int i = T >> 1, hh = T & 1;
#pragma unroll
            for (int jj = 0; jj < 4; ++jj) S[T][jj] = okm[hh][jj] ? S[T][jj] * 0.125f + bl[i * 64 + 16 * hh + jj] : -1.0e30f;
        } else {
#pragma unroll
            for (int jj = 0; jj < 4; ++jj) S[T][jj] *= 0.125f; }
#pragma unroll
        for (int jj = 0; jj < 4; ++jj) mx = fmaxf(mx, S[T][jj]);
    }
    mx = fmaxf(mx, __shfl_xor(mx, 16, 64)); mx = fmaxf(mx, __shfl_xor(mx, 32, 64));
    const float mb = mx * 1.4426950408889634f;
    u32x2 Pk[NT];
#pragma unroll
    for (int T = 0; T < NT; ++T) { float e[4];
#pragma unroll
        for (int jj = 0; jj < 4; ++jj) e[jj] = __builtin_amdgcn_exp2f(S[T][jj] * 1.4426950408889634f - mb);
        Pk[T][0] = cvt_pk_bf16(e[0], e[1]); Pk[T][1] = cvt_pk_bf16(e[2], e[3]); }
    if (LAT) {
#pragma unroll
        for (int i = 0; i < 9; ++i) vreg[i] = *(const u32x4*)(vgl + 64 * i); }
#pragma unroll
    for (int i = 9; i < 13; ++i) vreg[i] = *(const u32x4*)(vgc + 64 * (i - 9));
    __syncthreads();
    { unsigned char* vw = smem + (tid >> 3) * VSTR + (tid & 7) * 16;
      if (LAT) {
#pragma unroll
          for (int i = 0; i < 9; ++i) *(u32x4*)(vw + 128 * i) = vreg[i]; }
#pragma unroll
      for (int i = 9; i < 13; ++i) *(u32x4*)(vw + 1152 + 128 * (i - 9)) = vreg[i]; }
    __syncthreads();
    if (has_next) att_load_k(TID, qkz, nlat, nb, nh, nrp, kreg);
    const bf16_t* zrow = qkz + (size_t)(qtok0 + c) * 3072 + 2048 + h * 64 + 4 * g;
    u32x2 zz[4];
#pragma unroll
    for (int db = 0; db < 4; ++db) zz[db] = *(const u32x2*)(zrow + 16 * db);
    f32x4 acc[4], accs = (f32x4){0.f, 0.f, 0.f, 0.f};
    const bf16x8 ones = (bf16x8){0x3F80, 0x3F80, 0x3F80, 0x3F80, 0x3F80, 0x3F80, 0x3F80, 0x3F80};
#pragma unroll
    for (int db = 0; db < 4; ++db) acc[db] = (f32x4){0.f, 0.f, 0.f, 0.f};
#pragma unroll
    for (int ks = 0; ks < NT / 2; ++ks) {
        const int T0 = 2 * ks; const int vcol0 = (LAT && T0 < 16) ? rowoff + (T0 >> 1) * 64 + bs : 576 + 16 * (T0 - (LAT ? 16 : 0));
        union { u32x4 u; bf16x8 v; } pb; pb.u[0] = Pk[T0][0]; pb.u[1] = Pk[T0][1]; pb.u[2] = Pk[T0 + 1][0]; pb.u[3] = Pk[T0 + 1][1];
#pragma unroll
        for (int db = 0; db < 4; ++db) { const unsigned char* vp = smem + (16 * db + c) * VSTR + (vcol0 + 4 * g) * 2;
            union { u32x4 u; bf16x8 v; } va; const u32x2 lo = *(const u32x2*)vp, hi = *(const u32x2*)(vp + 32); va.u[0] = lo[0]; va.u[1] = lo[1]; va.u[2] = hi[0]; va.u[3] = hi[1];
            acc[db] = __builtin_amdgcn_mfma_f32_16x16x32_bf16(va.v, pb.v, acc[db], 0, 0, 0); }
        accs = __builtin_amdgcn_mfma_f32_16x16x32_bf16(ones, pb.v, accs, 0, 0, 0);
    }
    const float inv = 1.0f / accs[0];
    bf16_t* orow = og + (size_t)(qtok0 + c) * DM + h * 64 + 4 * g;
#pragma unroll
    for (int db = 0; db < 4; ++db) { u32x2 o;
        o[0] = cvt_pk_bf16(acc[db][0] * inv * silu_f(bflo(zz[db][0])), acc[db][1] * inv * silu_f(bfhi(zz[db][0])));
        o[1] = cvt_pk_bf16(acc[db][2] * inv * silu_f(bflo(zz[db][1])), acc[db][3] * inv * silu_f(bfhi(zz[db][1])));
        *(u32x2*)(orow + 16 * db) = o; }
}
__device__ __forceinline__ void att_decode(int item, bool& isctx, int& b, int& h, int& rp) {
    isctx = item >= 4096;
    if (!isctx) { rp = item & 31; h = (item >> 5) & 15; b = item >> 9; } else { const int i2 = item - 4096; rp = i2 & 1; h = (i2 >> 1) & 15; b = i2 >> 5; }
}
__device__ __forceinline__ void phase_att(int TID, int BID, const P& p, int jn, unsigned char* smem) {
    const bf16_t* qkz = (const bf16_t*)(p.ws + OFF_QKVZ); const bf16_t* vt = (const bf16_t*)(p.ws + OFF_VT); bf16_t* og = (bf16_t*)(p.ws + OFF_HOG);
    const bool xmap = gridDim.x == 256;
    const int nit = xmap ? 17 : (4352 + (int)gridDim.x - 1) / (int)gridDim.x;
#define ATT_ITEM(k) (xmap ? ((k) < 16 ? (((k) * 8 + (BID & 7)) * 32 + (BID >> 3)) : 4096 + BID) : BID + (k) * (int)gridDim.x)
    u32x4 kreg[13];
    { bool ic; int b0, h0, rp0; const int it0 = ATT_ITEM(0); if (it0 < 4352) { att_decode(it0, ic, b0, h0, rp0); att_load_k(TID, qkz, !ic, b0, h0, rp0, kreg); } }
    for (int k = 0; k < nit; ++k) {
        const int item = ATT_ITEM(k);
        if (item >= 4352) break;
        bool isctx, nctx = false; int b, h, rp, nb = 0, nh = 0, nrp = 0; att_decode(item, isctx, b, h, rp);
        const int nitem = (k + 1 < nit) ? ATT_ITEM(k + 1) : 4352; const bool has_next = nitem < 4352;
        if (has_next) att_decode(nitem, nctx, nb, nh, nrp);
        const float* rpb_g = p.na_rpb + ((size_t)jn * 16 + h) * 465;
        int t2 = TID; asm volatile("" : "+v"(t2));
        if (!isctx) att_item<true>(t2, qkz, vt, og, smem, rpb_g, b, h, rp, kreg, has_next, !nctx, nb, nh, nrp);
        else att_item<false>(t2, qkz, vt, og, smem, rpb_g, b, h, rp, kreg, has_next, !nctx, nb, nh, nrp);
    }
#undef ATT_ITEM
    __syncthreads();
}

__device__ __forceinline__ void phase_g1(int TID, int BID, const P& p, int layer, bool na, int ntok, unsigned char* smem) {
    GSched S; const char* h = (const char*)(p.ws + OFF_HOG); const char* wt = (const char*)(p.ws + OFF_WTIN);
    S.G = gridDim.x; S.c = BID;
    EpiStore E;
    if (na) { S.A0 = h; S.B0 = wt; S.nM0 = ntok / 256; S.nN0 = 12; S.A1 = wt + (size_t)3072 * 1024 * 2; S.B1 = h; S.nM1 = 4; S.nN1 = ntok / 256;
        E.O0 = (bf16_t*)(p.ws + OFF_QKVZ); E.ld0 = 3072; E.O1 = (bf16_t*)(p.ws + OFF_VT); E.ld1 = LDT; }
    else { S.A0 = wt; S.B0 = h; S.nM0 = 16; S.nN0 = ntok / 256; S.A1 = wt; S.B1 = h; S.nM1 = 0; S.nN1 = 0;
        E.O0 = (bf16_t*)(p.ws + OFF_QKVZ); E.ld0 = LDT; E.O1 = E.O0; E.ld1 = LDT; }
    gemm_phase<EpiStore>(TID, (LAS unsigned char*)smem, S, E);
}
__device__ __forceinline__ void phase_g2(int TID, int BID, const P& p, int layer, int ntok, unsigned char* smem) {
    GSched S; S.G = gridDim.x; S.c = BID;
    S.A0 = (const char*)(p.ws + OFF_HOG); S.B0 = (const char*)(p.ws + OFF_WTOUT); S.nM0 = ntok / 256; S.nN0 = 4; S.A1 = S.A0; S.B1 = S.B0; S.nM1 = 0; S.nN1 = 0;
    EpiStore E; E.O0 = (bf16_t*)(p.ws + OFF_Y); E.ld0 = DM; E.O1 = E.O0; E.ld1 = DM;
    gemm_phase<EpiStore>(TID, (LAS unsigned char*)smem, S, E);
}
__device__ __forceinline__ void run_phase(int TID, int BID, const P& p, int ph, unsigned char* smem) {
    if (ph == 0) {
#if DEBUG_CHECK & 1
        if (BID == 0) dbg_fft_test(TID, p, smem);
#endif
        phase_ada(TID, BID, p, smem); filter_mlp(TID, BID, p, smem); return; }
    if (ph == NPHASE - 1) { lnmod_rows(TID, BID, p, 4, NLAT);
#if DEBUG_CHECK
        __syncthreads(); if (BID == 0 && TID == 0) { p.out[0] = 1000.0f * fmaxf(__uint_as_float(*(volatile unsigned*)(p.ws + WS_END)), __uint_as_float(*(volatile unsigned*)(p.ws + WS_END + 4))); }
#endif
        return; }
    const int q = ph - 1, lp = q / 10, r = q % 10;
    if (r < 4) { const int layer = 2 * lp;
        if (r == 0) { lnmod_rows(TID, BID, p, layer, NTOK); wconv_tiles(TID, BID, (int)gridDim.x, 0, 1280, p, layer, true, smem); }
        else if (r == 1) phase_g1(TID, BID, p, layer, true, NTOK, smem);
        else if (r == 2) phase_att(TID, BID, p, lp, smem);
        else phase_g2(TID, BID, p, layer, NTOK, smem);
    } else { const int layer = 2 * lp + 1, r2 = r - 4; const bool last = layer == 3; const int ntok = last ? NLAT : NTOK;
        if (r2 == 0) { lnmod_rows(TID, BID, p, layer, ntok); wconv_tiles(TID, BID, (int)gridDim.x, 0, 1280, p, layer, false, smem); filter_taps(TID, BID, (int)gridDim.x, p, lp, !last, smem); }
        else if (r2 == 1) phase_f2(TID, BID, p, !last, smem);
        else if (r2 == 2) phase_g1(TID, BID, p, layer, false, ntok, smem);
        else if (r2 == 3) phase_conv(TID, BID, p, lp, !last, smem);
        else if (r2 == 4) phase_transpose(TID, BID, p, ntok, smem);
        else phase_g2(TID, BID, p, layer, ntok, smem);
    }
}

#define XB_TMO      128
#define XB_XCNT(j)  (256  + 64 * (j))
#define XB_XSUB(j)  (1280 + 64 * (j))
#define XB_XGEN(j)  (2304 + 64 * (j))
#define XB_TOP      3328
#define XB_TOPGEN   3392
#define XCD_BAR_WORDS 3456
#define XB_SPIN_CAP (1u << 18)
__device__ __forceinline__ unsigned xb_ld(unsigned* p)              { return __hip_atomic_load(p, __ATOMIC_RELAXED, __HIP_MEMORY_SCOPE_AGENT); }
__device__ __forceinline__ unsigned xb_add(unsigned* p, unsigned v) { return __hip_atomic_fetch_add(p, v, __ATOMIC_RELAXED, __HIP_MEMORY_SCOPE_AGENT); }
__device__ __forceinline__ unsigned xb_xcc_id() { return (unsigned)__builtin_amdgcn_s_getreg((3 << 11) | 20) & 0xFu; }
#define XB_SPIN(cond, bar) do { unsigned _sp = 0; while (cond) { __builtin_amdgcn_s_sleep(1); \
    if ((++_sp & 255u) == 0u) { if (xb_ld(&(bar)[XB_TMO])) break; if (_sp > XB_SPIN_CAP) { atomicAdd(&(bar)[XB_TMO], 1u); break; } } } } while (0)
struct XcdBarrier { unsigned* bar; unsigned x; volatile LAS unsigned* st; };
__device__ __forceinline__ XcdBarrier xcd_barrier_post(unsigned* bar, volatile LAS unsigned* st) {
    XcdBarrier b; b.bar = bar; b.x = xb_xcc_id(); b.st = st;
    if (threadIdx.x == 0) (void)xb_add(&bar[XB_XCNT(b.x)], 1u);
    return b;
}
__device__ __forceinline__ void xcd_barrier_complete(unsigned* bar, unsigned x, unsigned& nloc, unsigned& nx) {
    const unsigned G = gridDim.x * gridDim.y * gridDim.z;
    unsigned sum, cnt, mine, sp = 0u;
    for (;;) {
        sum = 0u; cnt = 0u; mine = 0u;
#pragma unroll
        for (unsigned j = 0; j < 16; ++j) { const unsigned c = xb_ld(&bar[XB_XCNT(j)]); sum += c; cnt += (c > 0u) ? 1u : 0u; mine = (j == x) ? c : mine; }
        if (sum == G) break;
        __builtin_amdgcn_s_sleep(1);
        if ((++sp & 255u) == 0u) { if (xb_ld(&bar[XB_TMO])) break; if (sp > XB_SPIN_CAP) { atomicAdd(&bar[XB_TMO], 1u); break; } }
    }
    nloc = mine > 0u ? mine : 1u; nx = cnt > 0u ? cnt : 1u;
}
__device__ __forceinline__ void xcd_barrier(const XcdBarrier& b) {
    asm volatile("s_waitcnt vmcnt(0)" ::: "memory");
    __syncthreads();
    if (threadIdx.x == 0) {
        unsigned* bar = b.bar;
        __builtin_amdgcn_s_waitcnt(0);
        unsigned nloc = b.st[0], nx = b.st[1];
        if (nloc == 0u) { xcd_barrier_complete(bar, b.x, nloc, nx); b.st[0] = nloc; b.st[1] = nx; }
        const unsigned old = xb_add(&bar[XB_XSUB(b.x)], 1u);
        const unsigned gen = old / nloc;
        if (old + 1u == (gen + 1u) * nloc) {
            __builtin_amdgcn_fence(__ATOMIC_RELEASE, "agent");
            asm volatile("s_waitcnt vmcnt(0)" ::: "memory");
            const unsigned og = xb_add(&bar[XB_TOP], 1u);
            const unsigned tg = og / nx;
            if (og + 1u == (tg + 1u) * nx) xb_add(&bar[XB_TOPGEN], 1u);
            else XB_SPIN(xb_ld(&bar[XB_TOPGEN]) == tg, bar);
            __builtin_amdgcn_fence(__ATOMIC_ACQUIRE, "agent");
            xb_add(&bar[XB_XGEN(b.x)], 1u);
            asm volatile("s_waitcnt vmcnt(0)" ::: "memory");
        } else {
            XB_SPIN(xb_ld(&bar[XB_XGEN(b.x)]) == gen, bar);
            __builtin_amdgcn_fence(__ATOMIC_ACQUIRE, "agent");
            asm volatile("s_waitcnt vmcnt(0)" ::: "memory");
        }
    }
    __syncthreads();
}

__device__ __forceinline__ int phase_kind(int ph) {
    if (ph == 0) return 0; if (ph == NPHASE - 1) return 11; const int r = (ph - 1) % 10; return 1 + r;
}
__global__ void __launch_bounds__(512) fwd_mega(P p) {
    extern __shared__ __attribute__((aligned(16))) unsigned char smem[];
    cg::grid_group grid = cg::this_grid();
    volatile LAS unsigned* st = (volatile LAS unsigned*)((LAS unsigned char*)smem + 139392);
    if (threadIdx.x == 0) { st[0] = 0u; st[1] = 0u; }
    __syncthreads();
    const XcdBarrier xb = xcd_barrier_post((unsigned*)(p.ws + OFF_BAR), st);
    if (p.ph_hi > NPHASE) grid.sync();
    const int wid_s = __builtin_amdgcn_readfirstlane((int)threadIdx.x >> 6);
    for (int ph = p.ph_lo; ph < p.ph_hi; ++ph) {
        unsigned zero_s; asm volatile("s_mov_b32 %0, 0" : "=s"(zero_s));
        int TID = (wid_s << 6) | (int)__builtin_amdgcn_mbcnt_hi(~0u, __builtin_amdgcn_mbcnt_lo(~0u, zero_s)), BID = blockIdx.x;
        asm volatile("" : "+v"(TID));
        asm volatile("" : "+s"(BID));
#if PROBE_KIND >= 0
        const unsigned long long t0 = wall_clock64();
#endif
        run_phase(TID, BID, p, ph, smem);
        if (ph + 1 < p.ph_hi) xcd_barrier(xb);
#if PROBE_KIND >= 0
        if (phase_kind(ph) == PROBE_KIND && ph + 1 < p.ph_hi) { const unsigned long long t1 = wall_clock64(); while (wall_clock64() - t1 < t1 - t0) __builtin_amdgcn_s_sleep(8); }
#endif
    }
}

extern "C" void kernel_launch(void* const* d_in, const int* in_sizes, int n_in, void* d_out, int out_size, void* d_ws, size_t ws_size, hipStream_t stream) {
    static int grid_blocks = 0;
    if (grid_blocks == 0) {
        if (n_in != 22 || ws_size < WS_END + 64) { fprintf(stderr, "kernel_launch: unexpected n_in %d or ws_size %zu (< %zu)\n", n_in, ws_size, (size_t)WS_END); grid_blocks = -1; return; }
        int dev = 0, cus = 0, per_cu = 0;
        (void)hipGetDevice(&dev); (void)hipDeviceGetAttribute(&cus, hipDeviceAttributeMultiprocessorCount, dev);
        if (hipFuncSetAttribute((const void*)fwd_mega, hipFuncAttributeMaxDynamicSharedMemorySize, LDS_BYTES) != hipSuccess) { fprintf(stderr, "kernel_launch: hipFuncSetAttribute failed\n"); grid_blocks = -1; return; }
        if (hipOccupancyMaxActiveBlocksPerMultiprocessor(&per_cu, (const void*)fwd_mega, 512, LDS_BYTES) != hipSuccess || per_cu < 1) { fprintf(stderr, "kernel_launch: occupancy query failed (%d)\n", per_cu); (void)hipGetLastError(); grid_blocks = -1; return; }
        grid_blocks = cus * per_cu;
        if (grid_blocks > 256) grid_blocks = 256;
    }
    if (grid_blocks < 0) return;
    if (hipMemsetAsync((char*)d_ws + OFF_BAR, 0, (size_t)XCD_BAR_WORDS * 4, stream) != hipSuccess) { fprintf(stderr, "kernel_launch: memset of the barrier words failed\n"); return; }
#if DEBUG_CHECK
    (void)hipMemsetAsync((char*)d_ws + WS_END, 0, 64, stream);
#endif
    P p{};
    const float** f = (const float**)&p;
    for (int i = 0; i < 22; ++i) f[i] = (const float*)d_in[i];
    p.out = (float*)d_out; p.ws = (unsigned char*)d_ws;
#if SINGLE_LAUNCH
    p.ph_lo = 0; p.ph_hi = NPHASE;
    void* args[] = {&p};
    hipError_t e = hipLaunchCooperativeKernel((const void*)fwd_mega, dim3(grid_blocks), dim3(512), args, LDS_BYTES, stream);
    if (e != hipSuccess) fprintf(stderr, "cooperative launch failed: %s (grid %d)\n", hipGetErrorString(e), grid_blocks);
#else
    for (int ph = 0; ph < NPHASE; ++ph) { p.ph_lo = ph; p.ph_hi = ph + 1; hipLaunchKernelGGL(fwd_mega, dim3(grid_blocks), dim3(512), LDS_BYTES, stream, p); }
#endif
}
```

```cpp
#include <hip/hip_runtime.h>
#include <hip/hip_cooperative_groups.h>
#include <hip/hip_fp16.h>
#include <cstdio>
namespace cg = cooperative_groups;

#ifndef SINGLE_LAUNCH
#define SINGLE_LAUNCH 1
#endif

#ifndef PROBE_KIND
#define PROBE_KIND -1
#endif
#ifndef DEBUG_CHECK
#define DEBUG_CHECK 0
#endif
#define LAS __attribute__((address_space(3)))
typedef unsigned short bf16_t;
typedef short bf16x8 __attribute__((ext_vector_type(8)));
typedef short bf16x4 __attribute__((ext_vector_type(4)));
typedef float f32x4 __attribute__((ext_vector_type(4)));
typedef float f32x16 __attribute__((ext_vector_type(16)));
typedef unsigned u32x4 __attribute__((ext_vector_type(4)));
typedef unsigned u32x2 __attribute__((ext_vector_type(2)));
typedef float f32x2 __attribute__((ext_vector_type(2)));

constexpr int DM = 1024, NB = 8, SEQ = 4096, CTXL = 256, NLAT = NB * SEQ, NCTX = NB * CTXL, NTOK = NLAT + NCTX;
constexpr int LDT = NTOK;
constexpr float ALPHA_F = 1.681792830507429f;
constexpr float LN_EPS_F = 1e-5f;
constexpr int NPHASE = 22;
constexpr int FFT_N = 8192, FFT_PAD = 8704, FFT_BYTES = FFT_PAD * 8;
constexpr int LDS_BYTES = 2 * FFT_BYTES + 256;

constexpr size_t OFF_QKVZ = 0;
constexpr size_t OFF_VT = (size_t)NTOK * 3072 * 2;
constexpr size_t OFF_Y = (size_t)136 << 20;
constexpr size_t OFF_CIRC_LAT = 0, OFF_CIRC_CTX = (size_t)2 * 1024 * 8192 * 4;
constexpr size_t OFF_HOG = (size_t)NTOK * 4096 * 2;
constexpr size_t OFF_HLAT = OFF_HOG + (size_t)NTOK * 1024 * 2;
constexpr size_t OFF_HCTX = OFF_HLAT + (size_t)2 * 1024 * 8192 * 4;
constexpr size_t OFF_CTXBUF = OFF_HCTX + (size_t)2 * 1024 * 8192 * 4;
constexpr size_t OFF_WTIN = OFF_CTXBUF + (size_t)NCTX * 1024 * 4;
constexpr size_t OFF_WTOUT = OFF_WTIN + (size_t)4096 * 1024 * 2;
constexpr size_t OFF_MOD = OFF_WTOUT + (size_t)1024 * 1024 * 2;
constexpr size_t OFF_A3 = OFF_MOD + (size_t)4 * 9 * 3072 * 4;
constexpr size_t OFF_BAR = OFF_A3 + (size_t)2 * 4352 * 64 * 4;
constexpr size_t WS_END = OFF_BAR + (size_t)3456 * 4;

struct P {
    const float *x, *c, *ctx, *c_ctx, *w_ada, *b_ada, *w_in, *w_out, *ln_g, *ln_b, *na_rpb, *hy_conv_w, *hy_conv_b,
        *f_w1, *f_b1, *f_w2, *f_b2, *f_w3, *f_b3, *f_w4, *f_freq, *hy_skip;
    float* out; unsigned char* ws; int ph_lo, ph_hi;
};

__device__ __forceinline__ unsigned cvt_pk_bf16(float lo, float hi) { unsigned r; asm volatile("v_cvt_pk_bf16_f32 %0, %1, %2" : "=v"(r) : "v"(lo), "v"(hi)); return r; }
__device__ __forceinline__ float bf2f(unsigned short b) { return __uint_as_float(((unsigned)b) << 16); }
__device__ __forceinline__ float bflo(unsigned u) { return __uint_as_float(u << 16); }
__device__ __forceinline__ float bfhi(unsigned u) { return __uint_as_float(u & 0xffff0000u); }
__device__ __forceinline__ float wave_sum(float v) {
#pragma unroll
    for (int o = 32; o; o >>= 1) v += __shfl_xor(v, o, 64);
    return v;
}
__device__ __forceinline__ float sin_rev(float r) { return __builtin_amdgcn_sinf(r); }
__device__ __forceinline__ float cos_rev(float r) { return __builtin_amdgcn_cosf(r); }
__device__ __forceinline__ float fast_sin(float x) { return __builtin_amdgcn_sinf(x * 0.15915494309189535f); }
__device__ __forceinline__ float fast_exp(float x) { return __builtin_amdgcn_exp2f(x * 1.4426950408889634f); }
__device__ __forceinline__ float silu_f(float z) { return z * __builtin_amdgcn_rcpf(1.0f + fast_exp(-z)); }

constexpr int BM = 256, BK = 64, HALF = 128, HTB = HALF * BK * 2, NXCD = 8, WGM = 8;
__device__ __forceinline__ int lds_byte(int r, int c) { const int st = (r >> 4) * 2 + (c >> 5), rr = r & 15, cc = c & 31, ob = rr * 64 + cc * 2; return st * 1024 + (ob ^ (((ob >> 9) & 1) << 5)); }
__device__ __forceinline__ void stage_rc(int b, int& R, int& C) { const int st = b / 1024, sb = b % 1024, swz = sb ^ (((sb >> 9) & 1) << 5); R = (st >> 1) * 16 + swz / 64; C = (st & 1) * 32 + (swz % 64) / 2; }
__device__ __forceinline__ int perm32(int rho) { const int n = rho >> 4, i = rho & 15; return 8 * (i >> 2) + 4 * n + (i & 3); }

struct Unit { int pm, pn, sub; };
struct GSched {
    const char *A0, *B0, *A1, *B1; int nM0, nN0, nM1, nN1, G, c;
    __device__ __forceinline__ bool next(int i, Unit& u) const {
        long L = (long)i * G + c; const int n0 = nM0 * nN0; int sub = 0;
        if (L >= n0) { L -= n0; sub = 1; if (L >= (long)nM1 * nN1) return false; }
        const int nM = sub ? nM1 : nM0, nN = sub ? nN1 : nN0, nwg = nM * nN;
        int wgid = (int)L; { const int q = nwg / NXCD, r = nwg % NXCD, xcd = wgid % NXCD, off = wgid / NXCD; wgid = (xcd < r ? xcd * (q + 1) : r * (q + 1) + (xcd - r) * q) + off; }
        const int nig = WGM * nN, gid = wgid / nig, fm = gid * WGM, gsz = (nM - fm) < WGM ? (nM - fm) : WGM;
        u.pm = fm + ((wgid % nig) % gsz); u.pn = (wgid % nig) / gsz; u.sub = sub; return true;
    }
    __device__ __forceinline__ const char* aptr(const Unit& u) const { return (u.sub ? A1 : A0) + (size_t)u.pm * (256 * 1024 * 2); }
    __device__ __forceinline__ const char* bptr(const Unit& u) const { return (u.sub ? B1 : B0) + (size_t)u.pn * (256 * 1024 * 2); }
};

struct EpiStore {
    static constexpr bool PERM = true;
    bf16_t* O0; int ld0; bf16_t* O1; int ld1;
    __device__ __forceinline__ void operator()(const f32x4 (&acc)[2][2][4][2], const Unit& u, int wr, int wc, int fr, int fq) const {
        bf16_t* base = u.sub ? O1 : O0; const int ld = u.sub ? ld1 : ld0;
        const int row0 = u.pm * BM + wr * 64 + fr, col0 = u.pn * BM + wc * 32 + 8 * fq;
#pragma unroll
        for (int ai = 0; ai < 2; ++ai)
#pragma unroll
            for (int m = 0; m < 4; ++m) { bf16_t* rowp = base + (size_t)(row0 + ai * HALF + m * 16) * ld + col0;
#pragma unroll
                for (int bj = 0; bj < 2; ++bj) { const f32x4 v0 = acc[ai][bj][m][0], v1 = acc[ai][bj][m][1];
                    u32x4 o; o[0] = cvt_pk_bf16(v0[0], v0[1]); o[1] = cvt_pk_bf16(v0[2], v0[3]); o[2] = cvt_pk_bf16(v1[0], v1[1]); o[3] = cvt_pk_bf16(v1[2], v1[3]);
                    *(u32x4*)(rowp + bj * HALF) = o; } }
    }
};
template <class Epi>
__device__ __forceinline__ void gemm_phase(int TID, LAS unsigned char* lds, const GSched& S, const Epi& E) {
    const int tid = TID, wid = __builtin_amdgcn_readfirstlane(tid >> 6), lane = tid & 63, wr = wid >> 2, wc = wid & 3, fr = lane & 15, fq = lane >> 4;
    constexpr int K = 1024, nt = K / BK;
    unsigned voffA[2], voffB[2];
#pragma unroll
    for (int i = 0; i < 2; ++i) { int R, C; stage_rc(tid * 16 + i * 8192, R, C); const int Rb = Epi::PERM ? ((R & ~31) + perm32(R & 31)) : R;
        voffA[i] = (unsigned)(R * K + C) * 2u; voffB[i] = (unsigned)(Rb * K + C) * 2u; }
    const size_t kstep = (size_t)(BK * 2), hstep = (size_t)HALF * K * 2;
    const unsigned ldsw = (unsigned)wid * 1024u;
    const int aoff = lds_byte(wr * 64 + fr, fq * 8), boff = lds_byte(wc * 32 + fr, fq * 8);
#define G_SA(b, h) (((b) * 2 + (h)) * HTB)
#define G_SB(b, h) ((4 + (b) * 2 + (h)) * HTB)
#define G_STAGE(bufoff, gbase, voff) do { _Pragma("unroll") for (int _i = 0; _i < 2; ++_i) \
        __builtin_amdgcn_global_load_lds((const unsigned*)((const char*)(gbase) + (voff)[_i]), (LAS unsigned*)(lds + (bufoff) + ldsw + _i * 8192), 16, 0, 0); } while (0)
#define G_LDA(dst, b, h) do { _Pragma("unroll") for (int m = 0; m < 4; ++m) _Pragma("unroll") for (int k = 0; k < 2; ++k) dst[m][k] = *(const LAS bf16x8*)(lds + G_SA(b, h) + aoff + m * 2048 + k * 1024); } while (0)
#define G_LDB(dst, b, h) do { _Pragma("unroll") for (int n = 0; n < 2; ++n) _Pragma("unroll") for (int k = 0; k < 2; ++k) dst[n][k] = *(const LAS bf16x8*)(lds + G_SB(b, h) + boff + n * 2048 + k * 1024); } while (0)
#define G_MMA(ai, bj, At, Bt) do { __builtin_amdgcn_s_setprio(1); _Pragma("unroll") for (int m = 0; m < 4; ++m) _Pragma("unroll") for (int n = 0; n < 2; ++n) _Pragma("unroll") for (int k = 0; k < 2; ++k) \
        acc[ai][bj][m][n] = __builtin_amdgcn_mfma_f32_16x16x32_bf16(Bt[n][k], At[m][k], acc[ai][bj][m][n], 0, 0, 0); __builtin_amdgcn_s_setprio(0); } while (0)
#define G_WAIT_V(n) asm volatile("s_waitcnt vmcnt(" #n ")" ::: "memory")
#define G_WAIT_L(n) asm volatile("s_waitcnt lgkmcnt(" #n ")" ::: "memory")
#define G_BAR __builtin_amdgcn_s_barrier()
#define G_SCHED __builtin_amdgcn_sched_barrier(0)
    Unit cur, nxt; int ui = 0;
    if (!S.next(0, cur)) return;
    f32x4 acc[2][2][4][2];
#pragma unroll
    for (int a = 0; a < 2; ++a)
#pragma unroll
        for (int b = 0; b < 2; ++b)
#pragma unroll
            for (int m = 0; m < 4; ++m)
#pragma unroll
                for (int n = 0; n < 2; ++n) acc[a][b][m][n] = (f32x4){0.f, 0.f, 0.f, 0.f};
    bf16x8 At[4][2], B0[2][2], B1[2][2];
    const char* cA = S.aptr(cur); const char* cB = S.bptr(cur);
    G_STAGE(G_SB(0, 0), cB, voffB); G_STAGE(G_SA(0, 0), cA, voffA); G_STAGE(G_SB(0, 1), cB + hstep, voffB); G_STAGE(G_SA(0, 1), cA + hstep, voffA);
    if (wr == 1) G_BAR;
    G_WAIT_V(4); G_BAR;
    G_STAGE(G_SB(1, 0), cB + kstep, voffB); G_STAGE(G_SA(1, 0), cA + kstep, voffA); G_STAGE(G_SB(1, 1), cB + hstep + kstep, voffB);
    G_WAIT_V(6); G_BAR;
    for (;;) {
        const bool has_next = S.next(ui + 1, nxt);
        const char* nA = has_next ? S.aptr(nxt) : cA; const char* nB = has_next ? S.bptr(nxt) : cB;
        for (int t = 0; t < nt; t += 2) {
            const bool last = (t == nt - 2);
            const char* a1 = cA + (size_t)(t + 1) * kstep;
            const char* a2 = last ? nA : cA + (size_t)(t + 2) * kstep; const char* b2 = last ? nB : cB + (size_t)(t + 2) * kstep;
            const char* a3 = a2 + kstep; const char* b3 = b2 + kstep;
            G_LDB(B0, 0, 0); G_SCHED; G_LDA(At, 0, 0); G_STAGE(G_SA(1, 1), a1 + hstep, voffA);
            G_WAIT_L(8); G_BAR; G_WAIT_L(0); G_MMA(0, 0, At, B0); G_BAR; G_SCHED;
            G_LDB(B1, 0, 1); G_STAGE(G_SB(0, 0), b2, voffB);
            G_BAR; G_WAIT_L(0); G_MMA(0, 1, At, B1); G_BAR;
            G_LDA(At, 0, 1); G_STAGE(G_SA(0, 0), a2, voffA);
            G_BAR; G_WAIT_L(0); G_MMA(1, 0, At, B0); G_BAR; G_SCHED;
            G_STAGE(G_SB(0, 1), b2 + hstep, voffB);
            G_WAIT_V(6); G_BAR; G_MMA(1, 1, At, B1); G_BAR;
            G_LDB(B0, 1, 0); G_SCHED; G_LDA(At, 1, 0); G_STAGE(G_SA(0, 1), a2 + hstep, voffA);
            G_WAIT_L(8); G_BAR; G_WAIT_L(0); G_MMA(0, 0, At, B0); G_BAR; G_SCHED;
            G_LDB(B1, 1, 1); G_STAGE(G_SB(1, 0), b3, voffB);
            G_BAR; G_WAIT_L(0); G_MMA(0, 1, At, B1); G_BAR;
            G_LDA(At, 1, 1); G_STAGE(G_SA(1, 0), a3, voffA);
            G_BAR; G_WAIT_L(0); G_MMA(1, 0, At, B0); G_BAR; G_SCHED;
            G_STAGE(G_SB(1, 1), b3 + hstep, voffB);
            G_WAIT_V(6); G_BAR; G_MMA(1, 1, At, B1); G_BAR;
        }
        E(acc, cur, wr, wc, fr, fq);
        if (!has_next) break;
#pragma unroll
        for (int a = 0; a < 2; ++a)
#pragma unroll
            for (int b = 0; b < 2; ++b)
#pragma unroll
                for (int m = 0; m < 4; ++m)
#pragma unroll
                    for (int n = 0; n < 2; ++n) acc[a][b][m][n] = (f32x4){0.f, 0.f, 0.f, 0.f};
        cur = nxt; cA = nA; cB = nB; ++ui;
    }
    G_WAIT_V(0);
    if (wr == 0) G_BAR;
    G_BAR;
#undef G_SA
#undef G_SB
#undef G_STAGE
#undef G_LDA
#undef G_LDB
#undef G_MMA
#undef G_WAIT_V
#undef G_WAIT_L
#undef G_BAR
#undef G_SCHED
}

__device__ __forceinline__ void phase_ada(int TID, int BID, const P& p, unsigned char* smem) {
    float* sc = (float*)smem; float* red = sc + 9 * 1024;
    const int tid = TID;
    for (int idx = tid; idx < 9 * 1024; idx += 512) { const int b = idx >> 10, k = idx & 1023; const float c = b < 8 ? p.c[b * 1024 + k] : p.c_ctx[k]; sc[idx] = c / (1.0f + __expf(-c)); }
    __syncthreads();
    float* mod = (float*)(p.ws + OFF_MOD);
    for (int item = BID; item < 192; item += gridDim.x) {
        const int layer = item / 48, chunk = item % 48, cl = tid & 63, kq = tid >> 6, col = chunk * 64 + cl;
        const float* w = p.w_ada + (size_t)layer * 1024 * 3072 + col;
        float acc[9];
#pragma unroll
        for (int b = 0; b < 9; ++b) acc[b] = 0.f;
        for (int k = kq * 128; k < kq * 128 + 128; ++k) { const float wv = w[(size_t)k * 3072];
#pragma unroll
            for (int b = 0; b < 9; ++b) acc[b] += sc[b * 1024 + k] * wv; }
#pragma unroll
        for (int b = 0; b < 9; ++b) red[(kq * 9 + b) * 64 + cl] = acc[b];
        __syncthreads();
        for (int o = tid; o < 576; o += 512) { const int b = o >> 6, cc = o & 63; float s = p.b_ada[layer * 3072 + chunk * 64 + cc];
#pragma unroll
            for (int q = 0; q < 8; ++q) s += red[(q * 9 + b) * 64 + cc];
            mod[(size_t)(layer * 9 + b) * 3072 + chunk * 64 + cc] = s; }
        __syncthreads();
    }
}

__device__ __forceinline__ void lnmod_rows(int TID, int BID, const P& p, int layer, int ntok) {
    const int tid = TID, lane = tid & 63, wid = tid >> 6;
    const float* modb = (const float*)(p.ws + OFF_MOD);
    float* ctxbuf = (float*)(p.ws + OFF_CTXBUF);
    bf16_t* hog = (bf16_t*)(p.ws + OFF_HOG); const bf16_t* Y = (const bf16_t*)(p.ws + OFF_Y);
    const int nwv = gridDim.x * 8, wrank = BID * 8 + wid;
    const bool contig = (ntok % nwv) == 0; const int per = contig ? ntok / nwv : (ntok - wrank + nwv - 1) / nwv;
#define LN_ROW(k) (contig ? wrank * per + (k) : wrank + (k) * nwv)
#define LN_SRC(r) (layer <= 1 ? ((r) >= NLAT ? p.ctx + (size_t)((r) - NLAT) * DM : p.x + (size_t)(r) * DM) : ((r) >= NLAT ? ctxbuf + (size_t)((r) - NLAT) * DM : p.out + (size_t)(r) * DM))
    f32x4 vn[4]; u32x2 yn[4];
    f32x4 lg[4], lb[4], gt[4], sh[4], sc[4]; int bcur = -1;
    if (layer > 0) { const float* g = p.ln_g + (size_t)(layer - 1) * DM; const float* bb = p.ln_b + (size_t)(layer - 1) * DM;
#pragma unroll
        for (int e = 0; e < 4; ++e) { lg[e] = *(const f32x4*)(g + lane * 4 + 256 * e); lb[e] = *(const f32x4*)(bb + lane * 4 + 256 * e); } }
    if (per > 0) { const int row = LN_ROW(0); const float* src = LN_SRC(row);
#pragma unroll
        for (int e = 0; e < 4; ++e) { vn[e] = __builtin_nontemporal_load((const f32x4*)(src + lane * 4 + 256 * e)); if (layer > 0) yn[e] = __builtin_nontemporal_load((const u32x2*)(Y + (size_t)row * DM + lane * 4 + 256 * e)); } }
    for (int k = 0; k < per; ++k) {
        const int row = LN_ROW(k);
        const bool isc = row >= NLAT; const int bsel = isc ? 8 : (row >> 12);
        float* xb = isc ? ctxbuf + (size_t)(row - NLAT) * DM : p.out + (size_t)row * DM;
        f32x4 v[4]; u32x2 yc[4];
#pragma unroll
        for (int e = 0; e < 4; ++e) { v[e] = vn[e]; yc[e] = yn[e]; }
        if (k + 1 < per) { const int nrow = LN_ROW(k + 1); const float* src = LN_SRC(nrow);
#pragma unroll
            for (int e = 0; e < 4; ++e) { vn[e] = __builtin_nontemporal_load((const f32x4*)(src + lane * 4 + 256 * e)); if (layer > 0) yn[e] = __builtin_nontemporal_load((const u32x2*)(Y + (size_t)nrow * DM + lane * 4 + 256 * e)); } }
        if (bsel != bcur) { bcur = bsel;
            const float* grow = modb + (size_t)((layer > 0 ? layer - 1 : 0) * 9 + bsel) * 3072 + 2048; const float* mrow = modb + (size_t)((layer < 4 ? layer : 0) * 9 + bsel) * 3072;
#pragma unroll
            for (int e = 0; e < 4; ++e) { const int col = lane * 4 + 256 * e; if (layer > 0) gt[e] = *(const f32x4*)(grow + col); if (layer < 4) { sh[e] = *(const f32x4*)(mrow + col); sc[e] = *(const f32x4*)(mrow + 1024 + col); } } }
        if (layer > 0) {
#pragma unroll
            for (int e = 0; e < 4; ++e) { const u32x2 yy = yc[e];
                f32x4 yv; yv[0] = bflo(yy[0]); yv[1] = bfhi(yy[0]); yv[2] = bflo(yy[1]); yv[3] = bfhi(yy[1]);
                v[e] = v[e] * ALPHA_F + gt[e] * yv; }
            float s = 0.f, q = 0.f;
#pragma unroll
            for (int e = 0; e < 4; ++e)
#pragma unroll
                for (int i = 0; i < 4; ++i) { s += v[e][i]; q += v[e][i] * v[e][i]; }
#pragma unroll
            for (int o = 32; o; o >>= 1) { const float s2 = __shfl_xor(s, o, 64), q2 = __shfl_xor(q, o, 64); s += s2; q += q2; }
            const float mu = s * (1.0f / 1024.0f);
            const float rstd = rsqrtf(fmaxf(q * (1.0f / 1024.0f) - mu * mu, 0.f) + LN_EPS_F);
#pragma unroll
            for (int e = 0; e < 4; ++e) { v[e] = (v[e] - mu) * rstd * lg[e] + lb[e]; __builtin_nontemporal_store(v[e], (f32x4*)(xb + lane * 4 + 256 * e)); }
        }
        if (layer < 4) {
#pragma unroll
            for (int e = 0; e < 4; ++e) { const int col = lane * 4 + 256 * e;
                const f32x4 h = v[e] * (sc[e] + 1.0f) + sh[e]; u32x2 o; o[0] = cvt_pk_bf16(h[0], h[1]); o[1] = cvt_pk_bf16(h[2], h[3]);
                *(u32x2*)(hog + (size_t)row * DM + col) = o; }
        }
    }
#undef LN_SRC
#undef LN_ROW
}
__device__ __forceinline__ void wconv_decode(const P& p, int layer, int t, const float*& W, int& N, bf16_t*& dst, int& kt, int& ntl, bool& isin) {
    isin = t < 1024;
    if (isin) { W = p.w_in + (size_t)layer * 1024 * 4096; N = 4096; dst = (bf16_t*)(p.ws + OFF_WTIN); kt = t >> 6; ntl = t & 63; }
    else { const int t2 = t - 1024; W = p.w_out + (size_t)layer * 1024 * 1024; N = 1024; dst = (bf16_t*)(p.ws + OFF_WTOUT); kt = t2 >> 4; ntl = t2 & 15; }
}
__device__ __forceinline__ void wconv_tiles(int TID, int rank, int nranks, int t_lo, int t_hi, const P& p, int layer, bool na, unsigned char* smem) {
    constexpr int NG = 5, TS = 64 * 65;
    float* tile = (float*)smem;
    const int tid = TID;
    for (int t0 = t_lo + rank; t0 < t_hi; t0 += NG * nranks) {
        f32x4 v[NG][2];
#pragma unroll
        for (int g = 0; g < NG; ++g) { const int t = t0 + g * nranks;
            if (t < t_hi) { const float* W; int N, kt, ntl; bf16_t* dst; bool isin; wconv_decode(p, layer, t, W, N, dst, kt, ntl, isin);
#pragma unroll
                for (int i = 0; i < 2; ++i) { const int idx = tid + i * 512, r = idx >> 4, c4 = idx & 15; v[g][i] = __builtin_nontemporal_load((const f32x4*)(W + (size_t)(kt * 64 + r) * N + ntl * 64 + c4 * 4)); } } }
#pragma unroll
        for (int g = 0; g < NG; ++g) { const int t = t0 + g * nranks;
            if (t < t_hi) {
#pragma unroll
                for (int i = 0; i < 2; ++i) { const int idx = tid + i * 512, r = idx >> 4, c4 = idx & 15;
#pragma unroll
                    for (int e = 0; e < 4; ++e) tile[g * TS + r * 65 + c4 * 4 + e] = v[g][i][e]; } } }
        __syncthreads();
#pragma unroll
        for (int g = 0; g < NG; ++g) { const int t = t0 + g * nranks;
            if (t < t_hi) { const float* W; int N, kt, ntl; bf16_t* dst; bool isin; wconv_decode(p, layer, t, W, N, dst, kt, ntl, isin);
                const int nl = tid >> 3, kg = tid & 7; int n = ntl * 64 + nl;
                if (na && isin) { if (n >= 3072) n -= 1024; else if (n >= 2048) n += 1024; }
                float f[8];
#pragma unroll
                for (int e = 0; e < 8; ++e) f[e] = tile[g * TS + (kg * 8 + e) * 65 + nl];
                u32x4 o; o[0] = cvt_pk_bf16(f[0], f[1]); o[1] = cvt_pk_bf16(f[2], f[3]); o[2] = cvt_pk_bf16(f[4], f[5]); o[3] = cvt_pk_bf16(f[6], f[7]);
                *(u32x4*)(dst + (size_t)n * 1024 + kt * 64 + kg * 8) = o; } }
        __syncthreads();
    }
}
__device__ __forceinline__ void filter_mlp(int TID, int BID, const P& p, unsigned char* smem) {
    float* zf = (float*)(smem + 57344); float* a1 = zf + 32 * 33; float* a2 = a1 + 32 * 65;
    float* wl1 = (float*)(smem + 81920); float* wl2 = wl1 + 33 * 64; float* wl3 = wl2 + 4096;
    const int tid = TID; int jcur = -1;
    float* a3g = (float*)(p.ws + OFF_A3);
    for (int it = (int)gridDim.x - 1 - BID; it < 272; it += gridDim.x) {
        const int j = it / 136, it2 = it % 136; const bool isctx = it2 >= 128; const int ptile = isctx ? it2 - 128 : it2, L = isctx ? 256 : 4096;
        if (j != jcur) { jcur = j;
            const f32x4* g1 = (const f32x4*)(p.f_w1 + (size_t)j * 33 * 64); const f32x4* g2 = (const f32x4*)(p.f_w2 + (size_t)j * 4096); const f32x4* g3 = (const f32x4*)(p.f_w3 + (size_t)j * 4096);
            for (int idx = tid; idx < 528 + 2048; idx += 512) { const f32x4 v = idx < 528 ? g1[idx] : (idx < 1552 ? g2[idx - 528] : g3[idx - 1552]); *(f32x4*)(wl1 + 4 * idx) = v; } }
        const float *w1 = p.f_w1 + (size_t)j * 33 * 64, *b1 = p.f_b1 + j * 64, *w2 = p.f_w2 + (size_t)j * 4096, *b2 = p.f_b2 + j * 64, *w3 = p.f_w3 + (size_t)j * 4096, *b3 = p.f_b3 + j * 64, *fq = p.f_freq + j * 192;
        for (int idx = tid; idx < 32 * 33; idx += 512) { const int pos = idx / 33, e = idx % 33, i = ptile * 32 + pos; float val;
            if (e == 0) val = (float)i / (float)(L - 1);
            else { const int band = (e - 1) & 15; const float f = 1e-4f + (float)band * ((15.0f - 1e-4f) / 15.0f); const float rev = f * (float)i / (float)L; val = e <= 16 ? cos_rev(rev) : -sin_rev(rev); }
            zf[idx] = val; }
        __syncthreads();
        const int pos = tid >> 4, o0 = tid & 15;
        { float acc[4];
#pragma unroll
          for (int r = 0; r < 4; ++r) acc[r] = b1[o0 + 16 * r];
#pragma unroll 11
          for (int e = 0; e < 33; ++e) { const float zv = zf[pos * 33 + e];
#pragma unroll
              for (int r = 0; r < 4; ++r) acc[r] += zv * wl1[e * 64 + o0 + 16 * r]; }
#pragma unroll
          for (int r = 0; r < 4; ++r) a1[pos * 65 + o0 + 16 * r] = fast_sin(fq[o0 + 16 * r] * acc[r]); }
        __syncthreads();
        { float acc[4];
#pragma unroll
          for (int r = 0; r < 4; ++r) acc[r] = b2[o0 + 16 * r];
#pragma unroll 8
          for (int e = 0; e < 64; ++e) { const float zv = a1[pos * 65 + e];
#pragma unroll
              for (int r = 0; r < 4; ++r) acc[r] += zv * wl2[e * 64 + o0 + 16 * r]; }
#pragma unroll
          for (int r = 0; r < 4; ++r) a2[pos * 65 + o0 + 16 * r] = fast_sin(fq[64 + o0 + 16 * r] * acc[r]); }
        __syncthreads();
        { float acc[4];
#pragma unroll
          for (int r = 0; r < 4; ++r) acc[r] = b3[o0 + 16 * r];
#pragma unroll 8
          for (int e = 0; e < 64; ++e) { const float zv = a2[pos * 65 + e];
#pragma unroll
              for (int r = 0; r < 4; ++r) acc[r] += zv * wl3[e * 64 + o0 + 16 * r]; }
          const int row = (isctx ? 4096 : 0) + ptile * 32 + pos;
#pragma unroll
          for (int r = 0; r < 4; ++r) a3g[((size_t)j * 4352 + row) * 64 + o0 + 16 * r] = fast_sin(fq[128 + o0 + 16 * r] * acc[r]); }
        __syncthreads();
    }
}
__device__ __forceinline__ void filter_taps(int TID, int rank, int nranks, const P& p, int j, bool with_ctx, unsigned char* smem) {
    const int tid = TID, lane = tid & 63, wid = tid >> 6;
    const int nunits = (128 + (with_ctx ? 8 : 0)) * 128, nw = nranks * 8;
    const float* w4 = p.f_w4 + (size_t)j * 64 * 4096; const float* a3g = (const float*)(p.ws + OFF_A3) + (size_t)j * 4352 * 64;
    float* circ_lat = (float*)(p.ws + OFF_CIRC_LAT); float* circ_ctx = (float*)(p.ws + OFF_CIRC_CTX);
    const int pc = lane & 31, kh = lane >> 5;
    const int u0 = nw - 1 - (rank * 8 + wid); const bool same_ct = (nw & 127) == 0;
    float aw[32], dl[16]; int ctl = -1;
    for (int u = u0; u < nunits; u += nw) {
        const int pt = u >> 7, ct = u & 127; const bool isctx = pt >= 128; const int ptile = isctx ? pt - 128 : pt, L = isctx ? 256 : 4096;
        const int i = ptile * 32 + pc; const float tpos = (float)i / (float)(L - 1);
        const float* arow = a3g + (size_t)((isctx ? 4096 : 0) + i) * 64 + kh * 32;
        float bq[32];
#pragma unroll
        for (int e = 0; e < 8; ++e) { const f32x4 v = *(const f32x4*)(arow + 4 * e); bq[4 * e] = v[0]; bq[4 * e + 1] = v[1]; bq[4 * e + 2] = v[2]; bq[4 * e + 3] = v[3]; }
        const int ch0 = ct * 32, wb = ch0 & 1023;
        if (!same_ct || ctl != ct) { ctl = ct;
            const float* wcol = w4 + (size_t)(kh * 32) * 4096 + ch0 + pc;
#pragma unroll
            for (int s = 0; s < 32; ++s) aw[s] = wcol[(size_t)s * 4096];
#pragma unroll
            for (int v = 0; v < 16; ++v) { const int w = wb + 8 * (v >> 2) + 4 * kh + (v & 3);
                dl[v] = fabsf(-3.0701134573253945f + (-15.350567286626973f + 3.0701134573253945f) * ((float)w * (1.0f / 1023.0f))); } }
        f32x16 acc;
#pragma unroll
        for (int v = 0; v < 16; ++v) acc[v] = 0.f;
#pragma unroll
        for (int s = 0; s < 32; ++s) acc = __builtin_amdgcn_mfma_f32_32x32x2f32(aw[s], bq[s], acc, 0, 0, 0);
        const int o = ch0 >> 11, d = (ch0 >> 10) & 1;
#pragma unroll
        for (int v = 0; v < 16; ++v) { const int w = wb + 8 * (v >> 2) + 4 * kh + (v & 3);
            const float val = acc[v] * __expf(-tpos * dl[v]);
            if (!(d == 1 && i == 0)) { if (!isctx) circ_lat[(size_t)(o * 1024 + w) * 8192 + (d ? 8192 - i : i)] = val; else circ_ctx[(size_t)(o * 1024 + w) * 512 + (d ? 512 - i : i)] = val; } }
    }
}

__device__ __forceinline__ int phys(int pp) { return ((pp & ~15) | ((pp ^ (pp >> 4)) & 15)) + ((pp >> 8) << 4); }
__device__ __forceinline__ constexpr int brev(int x, int bits) { int r = 0; for (int i = 0; i < bits; ++i) r |= ((x >> i) & 1) << (bits - 1 - i); return r; }
__device__ __forceinline__ constexpr float tw_c(int i) {
    constexpr float T[16] = {1.0f, 0.98078528040323043f, 0.92387953251128674f, 0.83146961230254524f, 0.70710678118654757f, 0.55557023301960229f, 0.38268343236508984f, 0.19509032201612833f,
                             0.0f, -0.19509032201612833f, -0.38268343236508984f, -0.55557023301960229f, -0.70710678118654757f, -0.83146961230254524f, -0.92387953251128674f, -0.98078528040323043f};
    return T[i];
}
__device__ __forceinline__ constexpr float tw_s(int i) {
    constexpr float T[16] = {0.0f, 0.19509032201612825f, 0.38268343236508978f, 0.55557023301960218f, 0.70710678118654746f, 0.83146961230254524f, 0.92387953251128674f, 0.98078528040323043f,
                             1.0f, 0.98078528040323043f, 0.92387953251128674f, 0.83146961230254546f, 0.70710678118654757f, 0.55557023301960218f, 0.38268343236508989f, 0.19509032201612861f};
    return T[i];
}
__device__ __forceinline__ f32x2 mk2(float x, float y) { f32x2 r; r.x = x; r.y = y; return r; }
__device__ __forceinline__ f32x2 cswap(f32x2 v) { return __builtin_shufflevector(v, v, 1, 0); }
__device__ __forceinline__ f32x2 cmul_fwd(f32x2 v, float c, float s) { return v * c + cswap(v) * mk2(s, -s); }
__device__ __forceinline__ f32x2 cmul_inv(f32x2 v, float c, float s) { return v * c + cswap(v) * mk2(-s, s); }
__device__ __forceinline__ f32x2 mul_mi(f32x2 v) { return mk2(v.y, -v.x); }
__device__ __forceinline__ f32x2 mul_pi(f32x2 v) { return mk2(-v.y, v.x); }
template <int R, int S> __device__ __forceinline__ void dif_stage(f32x2 (&a)[R]) {
#pragma unroll
    for (int b = 0; b < R; b += 2 * S)
#pragma unroll
        for (int jj = 0; jj < S; ++jj) { const int i0 = b + jj, i1 = i0 + S, ti = jj * (16 / S);
            const f32x2 u = a[i0], v = a[i1]; a[i0] = u + v; const f32x2 d = u - v;
            if (ti == 0) a[i1] = d; else if (ti == 8) a[i1] = mul_mi(d); else a[i1] = cmul_fwd(d, tw_c(ti), tw_s(ti)); }
}
template <int R, int S> __device__ __forceinline__ void dit_stage(f32x2 (&a)[R]) {
#pragma unroll
    for (int b = 0; b < R; b += 2 * S)
#pragma unroll
        for (int jj = 0; jj < S; ++jj) { const int i0 = b + jj, i1 = i0 + S, ti = jj * (16 / S);
            const f32x2 u = a[i0], x = a[i1]; f32x2 v;
            if (ti == 0) v = x; else if (ti == 8) v = mul_pi(x); else v = cmul_inv(x, tw_c(ti), tw_s(ti));
            a[i0] = u + v; a[i1] = u - v; }
}
__device__ __forceinline__ void dif16(f32x2 (&a)[16]) { dif_stage<16, 8>(a); dif_stage<16, 4>(a); dif_stage<16, 2>(a); dif_stage<16, 1>(a); }
__device__ __forceinline__ void dit16(f32x2 (&a)[16]) { dit_stage<16, 1>(a); dit_stage<16, 2>(a); dit_stage<16, 4>(a); dit_stage<16, 8>(a); }

struct TwPow { float c1, s1, c2, s2, c4, s4, c8, s8, c16, s16; };
__device__ __forceinline__ TwPow make_tw(float rev) {
    TwPow t; t.c1 = cos_rev(rev); t.s1 = sin_rev(rev);
    t.c2 = t.c1 * t.c1 - t.s1 * t.s1; t.s2 = 2.0f * t.c1 * t.s1; t.c4 = t.c2 * t.c2 - t.s2 * t.s2; t.s4 = 2.0f * t.c2 * t.s2;
    t.c8 = t.c4 * t.c4 - t.s4 * t.s4; t.s8 = 2.0f * t.c4 * t.s4; t.c16 = t.c8 * t.c8 - t.s8 * t.s8; t.s16 = 2.0f * t.c8 * t.s8; return t;
}
__device__ __forceinline__ void tw_opaque(TwPow& t) { asm volatile("" : "+v"(t.c1), "+v"(t.s1), "+v"(t.c2), "+v"(t.s2), "+v"(t.c4), "+v"(t.s4), "+v"(t.c8), "+v"(t.s8), "+v"(t.c16), "+v"(t.s16)); }
#define TW_ACC(bit, cc, ss) if (m & bit) { if (!have) { c = cc; s = ss; have = true; } else { const float nc = c * cc - s * ss; s = c * ss + s * cc; c = nc; } }
__device__ __forceinline__ void tw_get_lo_first(const TwPow& t, int m, float& c, float& s) {
    bool have = false; c = 1.f; s = 0.f; TW_ACC(1, t.c1, t.s1) TW_ACC(2, t.c2, t.s2) TW_ACC(4, t.c4, t.s4) TW_ACC(8, t.c8, t.s8) TW_ACC(16, t.c16, t.s16)
}
__device__ __forceinline__ void tw_get_hi_first(const TwPow& t, int m, float& c, float& s) {
    bool have = false; c = 1.f; s = 0.f; TW_ACC(16, t.c16, t.s16) TW_ACC(8, t.c8, t.s8) TW_ACC(4, t.c4, t.s4) TW_ACC(2, t.c2, t.s2) TW_ACC(1, t.c1, t.s1)
}
__device__ __forceinline__ void tw_get_p1(const TwPow& t, int m, float& c, float& s) {
    bool have = false; c = 1.f; s = 0.f; TW_ACC(2, t.c2, t.s2) TW_ACC(4, t.c4, t.s4) TW_ACC(8, t.c8, t.s8) TW_ACC(16, t.c16, t.s16) TW_ACC(1, t.c1, t.s1)
}
#undef TW_ACC

template <bool FULL> __device__ __forceinline__ void fft_p1(f32x2* buf, int j) {
    asm volatile("" : "+v"(j));
    f32x2* bj = buf + phys(j);
    f32x2 a[16], d[16];
#pragma unroll
    for (int k = 0; k < 16; ++k) a[k] = bj[272 * k];
    if (FULL) {
#pragma unroll
        for (int k = 0; k < 16; ++k) { const f32x2 v = bj[272 * (k + 16)]; d[k] = a[k] - v; a[k] = a[k] + v; }
    } else {
#pragma unroll
        for (int k = 0; k < 16; ++k) d[k] = a[k];
    }
    TwPow tw = make_tw((float)j * (1.0f / 8192.0f));
    dif16(a);
#pragma unroll
    for (int i = 0; i < 16; ++i) { const int m = 2 * brev(i, 4); f32x2 x = a[i]; if (m != 0) { float c, sn; tw_get_p1(tw, m, c, sn); x = cmul_fwd(x, c, sn); } bj[272 * m] = x; }
    tw_opaque(tw);
#pragma unroll
    for (int k = 1; k < 16; ++k) { if (k == 8) d[k] = mul_mi(d[k]); else d[k] = cmul_fwd(d[k], tw_c(k), tw_s(k)); }
    dif16(d);
#pragma unroll
    for (int i = 0; i < 16; ++i) { const int m = 2 * brev(i, 4) + 1; float c, sn; tw_get_p1(tw, m, c, sn); bj[272 * m] = cmul_fwd(d[i], c, sn); }
}
__device__ __forceinline__ void fft_p2(f32x2* buf, int j) {
    asm volatile("" : "+v"(j));
#pragma unroll
    for (int i = 0; i < 2; ++i) { const int q = j + 256 * i, base = (q >> 4) * 256 + (q & 15), jj = q & 15;
        f32x2 a[16];
#pragma unroll
        for (int k = 0; k < 16; ++k) a[k] = buf[phys(base + 16 * k)];
        const TwPow tw = make_tw((float)jj * (1.0f / 256.0f));
        dif16(a);
#pragma unroll
        for (int idx = 0; idx < 16; ++idx) { const int m = brev(idx, 4); f32x2 x = a[idx];
            if (m != 0) { float c, sn; tw_get_lo_first(tw, m, c, sn); x = cmul_fwd(x, c, sn); }
            buf[phys(base + 16 * m)] = x; } }
}
__device__ __forceinline__ void fft_p3_mul_ia(f32x2* buf, int j, const u32x4 (&hpre)[8]) {
    asm volatile("" : "+v"(j));
#pragma unroll
    for (int i = 0; i < 2; ++i) { const int q = j + 256 * i;
        u32x4 hr[4];
#pragma unroll
        for (int e = 0; e < 4; ++e) hr[e] = hpre[4 * i + e];
        f32x2 a[16];
#pragma unroll
        for (int k = 0; k < 16; ++k) a[k] = buf[phys(16 * q + k)];
        dif16(a);
#pragma unroll
        for (int idx = 0; idx < 16; ++idx) { const int m = brev(idx, 4); const unsigned hu = hr[m >> 2][m & 3];
            const float hx = __half2float(__ushort_as_half((unsigned short)(hu & 0xffffu))), hy = __half2float(__ushort_as_half((unsigned short)(hu >> 16)));
            a[idx] = a[idx] * hx + cswap(a[idx]) * mk2(-hy, hy); }
        dit16(a);
#pragma unroll
        for (int k = 0; k < 16; ++k) buf[phys(16 * q + k)] = a[k]; }
}
__device__ __forceinline__ void fft_ib(f32x2* buf, int j) {
    asm volatile("" : "+v"(j));
#pragma unroll
    for (int i = 0; i < 2; ++i) { const int q = j + 256 * i, base = (q >> 4) * 256 + (q & 15), jj = q & 15;
        f32x2 a[16];
        const TwPow tw = make_tw((float)jj * (1.0f / 256.0f));
#pragma unroll
        for (int m = 0; m < 16; ++m) { const int idx = brev(m, 4); f32x2 x = buf[phys(base + 16 * m)];
            if (m != 0) { float c, sn; tw_get_hi_first(tw, m, c, sn); x = cmul_inv(x, c, sn); }
            a[idx] = x; }
        dit16(a);
#pragma unroll
        for (int k = 0; k < 16; ++k) buf[phys(base + 16 * k)] = a[k]; }
}
__device__ __forceinline__ void fft_ic(f32x2* buf, int j) {
    asm volatile("" : "+v"(j));
    f32x2* bj = buf + phys(j);
    f32x2 u[16], v[16];
    TwPow tw = make_tw((float)j * (1.0f / 8192.0f));
#pragma unroll
    for (int mm = 0; mm < 16; ++mm) { const int idx = brev(mm, 4), m = 2 * mm; f32x2 x = bj[272 * m]; if (m != 0) { float c, sn; tw_get_hi_first(tw, m, c, sn); x = cmul_inv(x, c, sn); } u[idx] = x; }
    dit16(u);
    tw_opaque(tw);
#pragma unroll
    for (int mm = 0; mm < 16; ++mm) { const int idx = brev(mm, 4), m = 2 * mm + 1; float c, sn; tw_get_hi_first(tw, m, c, sn); v[idx] = cmul_inv(bj[272 * m], c, sn); }
    dit16(v);
#pragma unroll
    for (int k = 0; k < 16; ++k) { f32x2 x = v[k];
        if (k == 8) x = mul_pi(x); else if (k != 0) x = cmul_inv(x, tw_c(k), tw_s(k));
        bj[272 * k] = u[k] + x; }
}
__device__ __forceinline__ void conv_core(f32x2* buf, int j, const unsigned* H) {
    fft_p1<false>(buf, j); __syncthreads();
    u32x4 hpre[8];
#pragma unroll
    for (int e = 0; e < 4; ++e) { hpre[e] = *(const u32x4*)(H + 16 * j + 4 * e); hpre[4 + e] = *(const u32x4*)(H + 16 * (j + 256) + 4 * e); }
    fft_p2(buf, j); __syncthreads();
    fft_p3_mul_ia(buf, j, hpre); __syncthreads();
    fft_ib(buf, j); __syncthreads();
    fft_ic(buf, j); __syncthreads();
}

#if DEBUG_CHECK & 1
__device__ __forceinline__ float dbg_hash(unsigned x) { x ^= x >> 16; x *= 0x7feb352du; x ^= x >> 15; x *= 0x846ca68bu; x ^= x >> 16; return (float)(x & 0xffffff) * (1.0f / 8388608.0f) - 1.0f; }
__device__ __forceinline__ void dbg_fft_test(int TID, const P& p, unsigned char* smem) {
    const int tid = TID, grp = tid >> 8, j = tid & 255;
    f32x2* buf = (f32x2*)(smem + grp * FFT_BYTES);
    unsigned* Hd = (unsigned*)(p.ws + OFF_HLAT) + (size_t)grp * 8192;
#pragma unroll
    for (int k = 0; k < 16; ++k) { buf[phys(16 * j + k)] = mk2(dbg_hash(16 * j + k + 12345) * (1.0f / 8192.0f), 0.f); buf[phys(4096 + 16 * j + k)] = mk2(dbg_hash(4096 + 16 * j + k + 12345) * (1.0f / 8192.0f), 0.f); }
    __syncthreads();
    fft_p1<true>(buf, j); __syncthreads();
    fft_p2(buf, j); __syncthreads();
#pragma unroll 1
    for (int i = 0; i < 2; ++i) { const int q = j + 256 * i; f32x2 a[16];
#pragma unroll
        for (int k = 0; k < 16; ++k) a[k] = buf[phys(16 * q + k)];
        dif16(a);
#pragma unroll
        for (int idx = 0; idx < 16; ++idx) { const int m = brev(idx, 4); Hd[16 * q + m] = (unsigned)__half_as_ushort(__float2half_rn(a[idx].x)) | ((unsigned)__half_as_ushort(__float2half_rn(a[idx].y)) << 16); } }
    __threadfence(); __syncthreads();
#pragma unroll
    for (int k = 0; k < 16; ++k) buf[phys(16 * j + k)] = mk2(dbg_hash(16 * j + k + 777), dbg_hash(16 * j + k + 99991));
    __syncthreads();
    conv_core(buf, j, Hd);
    const int t = 16 * j + 3; const f32x2 y = buf[phys(t)];
    float er = 0.f, ei = 0.f;
    for (int s2 = 0; s2 < 4096; ++s2) { const float kk = dbg_hash(((t - s2) & 8191) + 12345) * (1.0f / 8192.0f); er += kk * dbg_hash(s2 + 777); ei += kk * dbg_hash(s2 + 99991); }
    float dev = fmaxf(fabsf(y.x * (1.0f / 8192.0f) - er), fabsf(y.y * (1.0f / 8192.0f) - ei)) * (1.0f / 0.0026f);
#pragma unroll
    for (int o = 32; o; o >>= 1) dev = fmaxf(dev, __shfl_xor(dev, o, 64));
    if ((tid & 63) == 0) atomicMax((unsigned*)(p.ws + WS_END + 4), __float_as_uint(dev));
    __syncthreads();
}
#endif
__device__ __forceinline__ void f2_load(const float* circ_lat, const float* circ_ctx, bool active, bool isctx, int ow, int j, float (&lo)[16], float (&hi)[16]) {
#pragma unroll
    for (int k = 0; k < 16; ++k) { lo[k] = 0.f; hi[k] = 0.f; }
    if (active) {
        if (!isctx) { const float* src = circ_lat + (size_t)ow * 8192;
#pragma unroll
            for (int e = 0; e < 4; ++e) { const f32x4 a = __builtin_nontemporal_load((const f32x4*)(src + 16 * j + 4 * e)), b = __builtin_nontemporal_load((const f32x4*)(src + 4096 + 16 * j + 4 * e));
#pragma unroll
                for (int i = 0; i < 4; ++i) { lo[4 * e + i] = a[i]; hi[4 * e + i] = b[i]; } }
            if (j == 0) hi[0] = 0.f;
        } else { const float* src = circ_ctx + (size_t)ow * 512;
            if (j < 16) {
#pragma unroll
                for (int e = 0; e < 4; ++e) { const f32x4 a = *(const f32x4*)(src + 16 * j + 4 * e);
#pragma unroll
                    for (int i = 0; i < 4; ++i) lo[4 * e + i] = a[i]; } }
            if (j >= 240) {
#pragma unroll
                for (int e = 0; e < 4; ++e) { const f32x4 b = *(const f32x4*)(src + 16 * j - 3584 + 4 * e);
#pragma unroll
                    for (int i = 0; i < 4; ++i) hi[4 * e + i] = b[i]; }
                if (j == 240) hi[0] = 0.f; }
        }
    }
}
__device__ __forceinline__ void phase_f2(int TID, int BID, const P& p, bool with_ctx, unsigned char* smem) {
    const int tid = TID, grp = tid >> 8, j = tid & 255, lane = tid & 63, wg = (tid >> 6) & 3;
    f32x2* buf = (f32x2*)(smem + grp * FFT_BYTES); float* red = (float*)(smem + 2 * FFT_BYTES) + grp * 8;
    const int nitems = with_ctx ? 2048 : 1024, nrounds = (nitems + 2 * (int)gridDim.x - 1) / (2 * (int)gridDim.x);
    const float* circ_lat = (const float*)(p.ws + OFF_CIRC_LAT); const float* circ_ctx = (const float*)(p.ws + OFF_CIRC_CTX);
    for (int rd = 0; rd < nrounds; ++rd) {
        const int item = (rd * (int)gridDim.x + BID) * 2 + grp; const bool active = item < nitems, isctx = item >= 1024; const int w = item & 1023;
        { float lo[16], hi[16]; float s0, s1;
          f2_load(circ_lat, circ_ctx, active, isctx, w, j, lo, hi);
          s0 = 0.f;
#pragma unroll
          for (int k = 0; k < 16; ++k) s0 += fabsf(lo[k]) + fabsf(hi[k]);
#pragma unroll
          for (int k = 0; k < 16; ++k) { buf[phys(16 * j + k)].x = lo[k]; buf[phys(4096 + 16 * j + k)].x = hi[k]; }
          f2_load(circ_lat, circ_ctx, active, isctx, 1024 + w, j, lo, hi);
          s1 = 0.f;
#pragma unroll
          for (int k = 0; k < 16; ++k) s1 += fabsf(lo[k]) + fabsf(hi[k]);
#pragma unroll
          for (int k = 0; k < 16; ++k) { buf[phys(16 * j + k)].y = lo[k]; buf[phys(4096 + 16 * j + k)].y = hi[k]; }
          s0 = wave_sum(s0); s1 = wave_sum(s1);
          if (lane == 0) { red[wg] = s0; red[4 + wg] = s1; } }
        __syncthreads();
        const float inv0 = 0.5f / (red[0] + red[1] + red[2] + red[3]), inv1 = 0.5f / (red[4] + red[5] + red[6] + red[7]);
        fft_p1<true>(buf, j); __syncthreads();
        fft_p2(buf, j); __syncthreads();
#pragma unroll 1
        for (int i = 0; i < 2; ++i) { const int q = j + 256 * i;
            f32x2 a[16];
#pragma unroll
            for (int k = 0; k < 16; ++k) a[k] = buf[phys(16 * q + k)];
            dif16(a);
#pragma unroll
            for (int idx = 0; idx < 16; ++idx) { const int m = brev(idx, 4); buf[phys(16 * q + m)] = a[idx]; } }
        __syncthreads();
        unsigned* Hd0 = (unsigned*)(p.ws + (isctx ? OFF_HCTX : OFF_HLAT)) + (size_t)w * 8192; unsigned* Hd1 = Hd0 + (size_t)1024 * 8192;
#pragma unroll 1
        for (int i = 0; i < 2; ++i) { const int q = j + 256 * i;
            unsigned h0[16], h1[16];
#pragma unroll
            for (int m = 0; m < 16; ++m) { const int pp = 16 * q + m;
                const int f = (pp >> 8) + 32 * ((pp >> 4) & 15) + 512 * (pp & 15), fn = (8192 - f) & 8191, pn = ((fn & 31) << 8) | (((fn >> 5) & 15) << 4) | (fn >> 9);
                const f32x2 g = buf[phys(pp)], gn = buf[phys(pn)];
                const float ar = (g.x + gn.x) * inv0, ai = (g.y - gn.y) * inv0, br = (g.y + gn.y) * inv1, bi = (gn.x - g.x) * inv1;
                h0[m] = (unsigned)__half_as_ushort(__float2half_rn(ar)) | ((unsigned)__half_as_ushort(__float2half_rn(ai)) << 16);
                h1[m] = (unsigned)__half_as_ushort(__float2half_rn(br)) | ((unsigned)__half_as_ushort(__float2half_rn(bi)) << 16); }
            if (active) {
#pragma unroll
                for (int e = 0; e < 4; ++e) { u32x4 o; o[0] = h0[4 * e]; o[1] = h0[4 * e + 1]; o[2] = h0[4 * e + 2]; o[3] = h0[4 * e + 3]; *(u32x4*)(Hd0 + 16 * q + 4 * e) = o;
                    u32x4 o1; o1[0] = h1[4 * e]; o1[1] = h1[4 * e + 1]; o1[2] = h1[4 * e + 2]; o1[3] = h1[4 * e + 3]; *(u32x4*)(Hd1 + 16 * q + 4 * e) = o1; } } }
        __syncthreads();
#if DEBUG_CHECK & 8
        if (active && (rd == nrounds - 1 || rd == 0)) {
            __threadfence(); __syncthreads();
            unsigned x = (unsigned)(BID * 512 + tid) * 2654435761u + 777u + rd; x ^= x >> 16; x *= 0x7feb352du; x ^= x >> 15;
            const int f = (int)(x & 8191u), o = (int)((x >> 13) & 1u);
            float sr = 0.f, si = 0.f, nrm = 0.f;
            for (int pp = 0; pp < 8192; ++pp) { float tv;
                if (!isctx) tv = (pp == 4096) ? 0.f : circ_lat[(size_t)(o * 1024 + w) * 8192 + pp];
                else tv = (pp < 256) ? circ_ctx[(size_t)(o * 1024 + w) * 512 + pp] : ((pp > 7936) ? circ_ctx[(size_t)(o * 1024 + w) * 512 + pp - 7680] : 0.f);
                nrm += fabsf(tv); const float rev = (float)((f * pp) & 8191) * (1.0f / 8192.0f); sr += tv * cospif(2.0f * rev); si -= tv * sinpif(2.0f * rev); }
            const int pos = ((f & 31) << 8) | (((f >> 5) & 15) << 4) | (f >> 9);
            const unsigned hu = ((const unsigned*)(p.ws + (isctx ? OFF_HCTX : OFF_HLAT)))[(size_t)(o * 1024 + w) * 8192 + pos];
            const float hx = __half2float(__ushort_as_half((unsigned short)(hu & 0xffffu))), hy = __half2float(__ushort_as_half((unsigned short)(hu >> 16)));
            float dev = (fabsf(hx - sr / nrm) + fabsf(hy - si / nrm)) * 50.0f;
#pragma unroll
            for (int oo = 32; oo; oo >>= 1) dev = fmaxf(dev, __shfl_xor(dev, oo, 64));
            if ((tid & 63) == 0) atomicMax((unsigned*)(p.ws + WS_END), __float_as_uint(dev));
            __syncthreads();
        }
#endif
    }
}

__device__ __forceinline__ void load_row16(const bf16_t* seq, int t0, int L, bool valid, float (&v)[18]) {
    if (valid) { const u32x4 a = __builtin_nontemporal_load((const u32x4*)(seq + t0)), b = __builtin_nontemporal_load((const u32x4*)(seq + t0 + 8));
#pragma unroll
        for (int e = 0; e < 4; ++e) { v[1 + 2 * e] = bflo(a[e]); v[2 + 2 * e] = bfhi(a[e]); v[9 + 2 * e] = bflo(b[e]); v[10 + 2 * e] = bfhi(b[e]); }
        v[0] = t0 > 0 ? bf2f(seq[t0 - 1]) : 0.f; v[17] = (t0 + 16 < L) ? bf2f(seq[t0 + 16]) : 0.f;
    } else {
#pragma unroll
        for (int k = 0; k < 18; ++k) v[k] = 0.f; }
}
__device__ __forceinline__ void short_conv16(const bf16_t* seq, int t0, int L, bool valid, float w0, float w1, float w2, float bias, float (&o)[16]) {
    float v[18]; load_row16(seq, t0, L, valid, v);
#pragma unroll
    for (int k = 0; k < 16; ++k) o[k] = valid ? (w0 * v[k] + w1 * v[k + 1] + w2 * v[k + 2] + bias) : 0.f;
}
__device__ __forceinline__ void phase_conv(int TID, int BID, const P& p, int jh, bool with_ctx, unsigned char* smem) {
    const int tid = TID, grp = tid >> 8, j = tid & 255;
    f32x2* buf = (f32x2*)(smem + grp * FFT_BYTES);
    const int nitems = 4096 + (with_ctx ? 1024 : 0), nrounds = (nitems + 2 * (int)gridDim.x - 1) / (2 * (int)gridDim.x);
    bf16_t* projT = (bf16_t*)(p.ws + OFF_QKVZ);
    const float* cw = p.hy_conv_w + (size_t)jh * 3 * 3072; const float* cb = p.hy_conv_b + (size_t)jh * 3072; const float* skip = p.hy_skip + (size_t)jh * 2 * 1024;
    for (int rd = 0; rd < nrounds; ++rd) {
        const int item = (rd * (int)gridDim.x + BID) * 2 + grp; const bool active = item < nitems, isctx = item >= 4096;
        int c, t0, L, offRe, offIm; bool vRe, vIm;
        if (!isctx) { c = item >> 2; const int pair = item & 3; t0 = 16 * j; L = 4096; offRe = (2 * pair) * 4096; offIm = offRe + 4096; vRe = active; vIm = active; }
        else { c = item - 4096; t0 = 16 * (j & 31); L = 256; offRe = NLAT + (j >> 5) * 256; offIm = offRe; vRe = active && ((j & 31) < 16); vIm = false; }
        if (!active) c = 0;
        const bf16_t* rv = projT + (size_t)c * LDT; const bf16_t* rx1 = projT + (size_t)(1024 + c) * LDT; const bf16_t* rx2 = projT + (size_t)(2048 + c) * LDT; bf16_t* rg = projT + (size_t)(3072 + c) * LDT;
        const unsigned* H0 = (const unsigned*)(p.ws + (isctx ? OFF_HCTX : OFF_HLAT)) + (size_t)c * 8192; const unsigned* H1 = H0 + (size_t)1024 * 8192;
        float zr[16], zi[16];
        short_conv16(rv + offRe, t0, L, vRe, cw[c], cw[3072 + c], cw[6144 + c], cb[c], zr);
        short_conv16(rv + offIm, t0, L, vIm, cw[c], cw[3072 + c], cw[6144 + c], cb[c], zi);
#pragma unroll
        for (int k = 0; k < 16; ++k) buf[phys(16 * j + k)] = mk2(zr[k], zi[k]);
        __syncthreads();
        conv_core(buf, j, H0);
        { float xr[16], xi[16]; const float sk = skip[c];
          short_conv16(rx1 + offRe, t0, L, vRe, cw[1024 + c], cw[3072 + 1024 + c], cw[6144 + 1024 + c], cb[1024 + c], xr);
          short_conv16(rx1 + offIm, t0, L, vIm, cw[1024 + c], cw[3072 + 1024 + c], cw[6144 + 1024 + c], cb[1024 + c], xi);
#pragma unroll
          for (int k = 0; k < 16; ++k) { const f32x2 y = buf[phys(16 * j + k)];
              zr[k] = xr[k] * (y.x * (1.0f / 8192.0f) + zr[k] * sk); zi[k] = xi[k] * (y.y * (1.0f / 8192.0f) + zi[k] * sk);
              buf[phys(16 * j + k)] = mk2(zr[k], zi[k]); } }
        __syncthreads();
        conv_core(buf, j, H1);
        { float xr[16], xi[16]; const float sk = skip[1024 + c];
          short_conv16(rx2 + offRe, t0, L, vRe, cw[2048 + c], cw[3072 + 2048 + c], cw[6144 + 2048 + c], cb[2048 + c], xr);
          short_conv16(rx2 + offIm, t0, L, vIm, cw[2048 + c], cw[3072 + 2048 + c], cw[6144 + 2048 + c], cb[2048 + c], xi);
#pragma unroll
          for (int k = 0; k < 16; ++k) { const f32x2 y = buf[phys(16 * j + k)];
              zr[k] = xr[k] * (y.x * (1.0f / 8192.0f) + zr[k] * sk); zi[k] = xi[k] * (y.y * (1.0f / 8192.0f) + zi[k] * sk); } }
        if (vRe) { bf16_t* gp = rg + offRe + t0; const u32x4 a = __builtin_nontemporal_load((const u32x4*)gp), b = __builtin_nontemporal_load((const u32x4*)(gp + 8)); u32x4 oa, ob;
#pragma unroll
            for (int e = 0; e < 4; ++e) { oa[e] = cvt_pk_bf16(zr[2 * e] * silu_f(bflo(a[e])), zr[2 * e + 1] * silu_f(bfhi(a[e]))); ob[e] = cvt_pk_bf16(zr[8 + 2 * e] * silu_f(bflo(b[e])), zr[9 + 2 * e] * silu_f(bfhi(b[e]))); }
            *(u32x4*)gp = oa; *(u32x4*)(gp + 8) = ob; }
        if (vIm) { bf16_t* gp = rg + offIm + t0; const u32x4 a = __builtin_nontemporal_load((const u32x4*)gp), b = __builtin_nontemporal_load((const u32x4*)(gp + 8)); u32x4 oa, ob;
#pragma unroll
            for (int e = 0; e < 4; ++e) { oa[e] = cvt_pk_bf16(zi[2 * e] * silu_f(bflo(a[e])), zi[2 * e + 1] * silu_f(bfhi(a[e]))); ob[e] = cvt_pk_bf16(zi[8 + 2 * e] * silu_f(bflo(b[e])), zi[9 + 2 * e] * silu_f(bfhi(b[e]))); }
            *(u32x4*)gp = oa; *(u32x4*)(gp + 8) = ob; }
    }
}

__device__ __forceinline__ void phase_transpose(int TID, int BID, const P& p, int ntok, unsigned char* smem) {
    bf16_t* tile = (bf16_t*)smem;
    const int tid = TID; const bf16_t* src = (const bf16_t*)(p.ws + OFF_QKVZ) + (size_t)3072 * LDT; bf16_t* og = (bf16_t*)(p.ws + OFF_HOG);
    const int ntt = ntok / 256, ngroups = 16 * ntt;
    for (int t = BID; t < ngroups; t += gridDim.x) { const int ct = t / ntt, tt = t % ntt;
        { const int r = tid >> 3, ch = tid & 7; u32x4 v[4];
#pragma unroll
          for (int q = 0; q < 4; ++q) v[q] = __builtin_nontemporal_load((const u32x4*)(src + (size_t)(ct * 64 + r) * LDT + tt * 256 + q * 64 + ch * 8));
#pragma unroll
          for (int q = 0; q < 4; ++q) *(u32x4*)(tile + q * 4608 + r * 72 + ch * 8) = v[q]; }
        __syncthreads();
        { const int tk = tid >> 3, cg8 = tid & 7;
#pragma unroll
          for (int q = 0; q < 4; ++q) { unsigned short e[8];
#pragma unroll
              for (int i = 0; i < 8; ++i) e[i] = tile[q * 4608 + (cg8 * 8 + i) * 72 + tk];
              u32x4 o; o[0] = e[0] | ((unsigned)e[1] << 16); o[1] = e[2] | ((unsigned)e[3] << 16); o[2] = e[4] | ((unsigned)e[5] << 16); o[3] = e[6] | ((unsigned)e[7] << 16);
              *(u32x4*)(og + (size_t)(tt * 256 + q * 64 + tk) * DM + ct * 64 + cg8 * 8) = o; } }
        __syncthreads();
    }
}

__device__ __forceinline__ void att_load_k(int TID, const bf16_t* __restrict__ qkz, bool lat, int b, int h, int rp, u32x4 (&kreg)[13]) {
    const int R0 = min(min(max(2 * rp - 4, 0), 56), 55), tokL = b * 4096 + R0 * 64, ctx0 = NLAT + b * 256;
    const int toff = (TID >> 3) * 3072 + (TID & 7) * 8;
    const bf16_t* lbase = qkz + (size_t)tokL * 3072 + 1024 + h * 64; const bf16_t* cbase = qkz + (size_t)ctx0 * 3072 + 1024 + h * 64;
    if (lat) {
#pragma unroll
        for (int i = 0; i < 9; ++i) kreg[i] = *(const u32x4*)(lbase + (size_t)(64 * i) * 3072 + toff); }
#pragma unroll
    for (int i = 9; i < 13; ++i) kreg[i] = *(const u32x4*)(cbase + (size_t)(64 * (i - 9)) * 3072 + toff);
}
template <bool LAT>
__device__ __forceinline__ void att_item(int TID, const bf16_t* __restrict__ qkz, const bf16_t* __restrict__ vt, bf16_t* __restrict__ og, unsigned char* smem, const float* __restrict__ rpb_g, int b, int h, int rp,
                                         u32x4 (&kreg)[13], bool has_next, bool nlat, int nb, int nh, int nrp) {
    constexpr int NT = LAT ? 32 : 16, KSTR = 144, VSTR = 1680;
    const int tid = TID, lane = tid & 63, wid = tid >> 6, c = lane & 15, g = lane >> 4;
    float* rpb = (float*)(smem + 120064);
    int r = 0, n = 0, qtok0, r0 = 0, R0 = 0;
    if (LAT) { r = 2 * rp + (wid >> 2); n = wid & 3; qtok0 = b * 4096 + r * 64 + 16 * n; r0 = min(max(r - 4, 0), 56); R0 = min(min(max(2 * rp - 4, 0), 56), 55); }
    else qtok0 = NLAT + b * 256 + 16 * (8 * rp + wid);
    const int tokL = b * 4096 + R0 * 64, ctx0 = NLAT + b * 256, bs = min(max(16 * n - 8, 0), 32), rowoff = (r0 - R0) * 64;
    const bf16_t* qrow = qkz + (size_t)(qtok0 + c) * 3072 + h * 64 + 8 * g;
    const bf16x8 q0 = *(const bf16x8*)qrow, q1 = *(const bf16x8*)(qrow + 32);
    __syncthreads();
    { unsigned char* kw = smem + (tid >> 3) * KSTR + (tid & 7) * 16;
#pragma unroll
      for (int i = (LAT ? 0 : 9); i < 13; ++i) *(u32x4*)(kw + 64 * i * KSTR) = kreg[i]; }
    if (LAT && tid < 465) rpb[(tid / 31) * 64 + (tid % 31) + 16] = rpb_g[tid];
    __syncthreads();
    f32x4 S[NT];
#pragma unroll
    for (int T = 0; T < NT; ++T) {
        const int tl0 = (LAT && T < 16) ? rowoff + (T >> 1) * 64 + bs + (T & 1) * 16 : 576 + 16 * (T - (LAT ? 16 : 0));
        const unsigned char* kp = smem + (tl0 + c) * KSTR + g * 16;
        const bf16x8 k0 = *(const bf16x8*)kp, k1 = *(const bf16x8*)(kp + 64);
        f32x4 a = (f32x4){0.f, 0.f, 0.f, 0.f};
        a = __builtin_amdgcn_mfma_f32_16x16x32_bf16(k0, q0, a, 0, 0, 0);
        a = __builtin_amdgcn_mfma_f32_16x16x32_bf16(k1, q1, a, 0, 0, 0);
        S[T] = a;
    }
    u32x4 vreg[13];
    const bf16_t* vgl = vt + (size_t)(h * 64 + (tid >> 3)) * LDT + tokL + (tid & 7) * 8; const bf16_t* vgc = vt + (size_t)(h * 64 + (tid >> 3)) * LDT + ctx0 + (tid & 7) * 8;
    bool okm[2][4]; const float* bl = rpb;
    if (LAT) { const int cq = 16 * n + c, qs = min(max(cq - 8, 0), 48); bl = rpb + (r0 - r + 7) * 64 + (bs + 4 * g - cq + 31);
#pragma unroll
        for (int hh = 0; hh < 2; ++hh)
#pragma unroll
            for (int jj = 0; jj < 4; ++jj) okm[hh][jj] = (unsigned)(bs + 16 * hh + 4 * g + jj - qs) < 16u; }
    float mx = -3.0e38f;
#pragma unroll
    for (int T = 0; T < NT; ++T) {
        if (LAT && T < 16) { const int i = T >> 1, hh = T & 1;
#pragma unroll
            for (int jj = 0; jj < 4; ++jj) S[T][jj] = okm[hh][jj] ? S[T][jj] * 0.125f + bl[i * 64 + 16 * hh + jj] : -1.0e30f;
        } else {
#pragma unroll
            for (int jj = 0; jj < 4; ++jj) S[T][jj] *= 0.125f; }
#pragma unroll
        for (int jj = 0; jj < 4; ++jj) mx = fmaxf(mx, S[T][jj]);
    }
    mx = fmaxf(mx, __shfl_xor(mx, 16, 64)); mx = fmaxf(mx, __shfl_xor(mx, 32, 64));
    const float mb = mx * 1.4426950408889634f;
    u32x2 Pk[NT];
#pragma unroll
    for (int T = 0; T < NT; ++T) { float e[4];
#pragma unroll
        for (int jj = 0; jj < 4; ++jj) e[jj] = __builtin_amdgcn_exp2f(S[T][jj] * 1.4426950408889634f - mb);
        Pk[T][0] = cvt_pk_bf16(e[0], e[1]); Pk[T][1] = cvt_pk_bf16(e[2], e[3]); }
    if (LAT) {
#pragma unroll
        for (int i = 0; i < 9; ++i) vreg[i] = *(const u32x4*)(vgl + 64 * i); }
#pragma unroll
    for (int i = 9; i < 13; ++i) vreg[i] = *(const u32x4*)(vgc + 64 * (i - 9));
    __syncthreads();
    { unsigned char* vw = smem + (tid >> 3) * VSTR + (tid & 7) * 16;
      if (LAT) {
#pragma unroll
          for (int i = 0; i < 9; ++i) *(u32x4*)(vw + 128 * i) = vreg[i]; }
#pragma unroll
      for (int i = 9; i < 13; ++i) *(u32x4*)(vw + 1152 + 128 * (i - 9)) = vreg[i]; }
    __syncthreads();
    if (has_next) att_load_k(TID, qkz, nlat, nb, nh, nrp, kreg);
    const bf16_t* zrow = qkz + (size_t)(qtok0 + c) * 3072 + 2048 + h * 64 + 4 * g;
    u32x2 zz[4];
#pragma unroll
    for (int db = 0; db < 4; ++db) zz[db] = *(const u32x2*)(zrow + 16 * db);
    f32x4 acc[4], accs = (f32x4){0.f, 0.f, 0.f, 0.f};
    const bf16x8 ones = (bf16x8){0x3F80, 0x3F80, 0x3F80, 0x3F80, 0x3F80, 0x3F80, 0x3F80, 0x3F80};
#pragma unroll
    for (int db = 0; db < 4; ++db) acc[db] = (f32x4){0.f, 0.f, 0.f, 0.f};
#pragma unroll
    for (int ks = 0; ks < NT / 2; ++ks) {
        const int T0 = 2 * ks; const int vcol0 = (LAT && T0 < 16) ? rowoff + (T0 >> 1) * 64 + bs : 576 + 16 * (T0 - (LAT ? 16 : 0));
        union { u32x4 u; bf16x8 v; } pb; pb.u[0] = Pk[T0][0]; pb.u[1] = Pk[T0][1]; pb.u[2] = Pk[T0 + 1][0]; pb.u[3] = Pk[T0 + 1][1];
#pragma unroll
        for (int db = 0; db < 4; ++db) { const unsigned char* vp = smem + (16 * db + c) * VSTR + (vcol0 + 4 * g) * 2;
            union { u32x4 u; bf16x8 v; } va; const u32x2 lo = *(const u32x2*)vp, hi = *(const u32x2*)(vp + 32); va.u[0] = lo[0]; va.u[1] = lo[1]; va.u[2] = hi[0]; va.u[3] = hi[1];
            acc[db] = __builtin_amdgcn_mfma_f32_16x16x32_bf16(va.v, pb.v, acc[db], 0, 0, 0); }
        accs = __builtin_amdgcn_mfma_f32_16x16x32_bf16(ones, pb.v, accs, 0, 0, 0);
    }
    const float inv = 1.0f / accs[0];
    bf16_t* orow = og + (size_t)(qtok0 + c) * DM + h * 64 + 4 * g;
#pragma unroll
    for (int db = 0; db < 4; ++db) { u32x2 o;
        o[0] = cvt_pk_bf16(acc[db][0] * inv * silu_f(bflo(zz[db][0])), acc[db][1] * inv * silu_f(bfhi(zz[db][0])));
        o[1] = cvt_pk_bf16(acc[db][2] * inv * silu_f(bflo(zz[db][1])), acc[db][3] * inv * silu_f(bfhi(zz[db][1])));
        *(u32x2*)(orow + 16 * db) = o; }
}
__device__ __forceinline__ void att_decode(int item, bool& isctx, int& b, int& h, int& rp) {
    isctx = item >= 4096;
    if (!isctx) { rp = item & 31; h = (item >> 5) & 15; b = item >> 9; } else { const int i2 = item - 4096; rp = i2 & 1; h = (i2 >> 1) & 15; b = i2 >> 5; }
}
__device__ __forceinline__ void phase_att(int TID, int BID, const P& p, int jn, unsigned char* smem) {
    const bf16_t* qkz = (const bf16_t*)(p.ws + OFF_QKVZ); const bf16_t* vt = (const bf16_t*)(p.ws + OFF_VT); bf16_t* og = (bf16_t*)(p.ws + OFF_HOG);
    const bool xmap = gridDim.x == 256;
    const int nit = xmap ? 17 : (4352 + (int)gridDim.x - 1) / (int)gridDim.x;
#define ATT_ITEM(k) (xmap ? ((k) < 16 ? (((k) * 8 + (BID & 7)) * 32 + (BID >> 3)) : 4096 + BID) : BID + (k) * (int)gridDim.x)
    u32x4 kreg[13];
    { bool ic; int b0, h0, rp0; const int it0 = ATT_ITEM(0); if (it0 < 4352) { att_decode(it0, ic, b0, h0, rp0); att_load_k(TID, qkz, !ic, b0, h0, rp0, kreg); } }
    for (int k = 0; k < nit; ++k) {
        const int item = ATT_ITEM(k);
        if (item >= 4352) break;
        bool isctx, nctx = false; int b, h, rp, nb = 0, nh = 0, nrp = 0; att_decode(item, isctx, b, h, rp);
        const int nitem = (k + 1 < nit) ? ATT_ITEM(k + 1) : 4352; const bool has_next = nitem < 4352;
        if (has_next) att_decode(nitem, nctx, nb, nh, nrp);
        const float* rpb_g = p.na_rpb + ((size_t)jn * 16 + h) * 465;
        int t2 = TID; asm volatile("" : "+v"(t2));
        if (!isctx) att_item<true>(t2, qkz, vt, og, smem, rpb_g, b, h, rp, kreg, has_next, !nctx, nb, nh, nrp);
        else att_item<false>(t2, qkz, vt, og, smem, rpb_g, b, h, rp, kreg, has_next, !nctx, nb, nh, nrp);
    }
#undef ATT_ITEM
    __syncthreads();
}

__device__ __forceinline__ void phase_g1(int TID, int BID, const P& p, int layer, bool na, int ntok, unsigned char* smem) {
    GSched S; const char* h = (const char*)(p.ws + OFF_HOG); const char* wt = (const char*)(p.ws + OFF_WTIN);
    S.G = gridDim.x; S.c = BID;
    EpiStore E;
    if (na) { S.A0 = h; S.B0 = wt; S.nM0 = ntok / 256; S.nN0 = 12; S.A1 = wt + (size_t)3072 * 1024 * 2; S.B1 = h; S.nM1 = 4; S.nN1 = ntok / 256;
        E.O0 = (bf16_t*)(p.ws + OFF_QKVZ); E.ld0 = 3072; E.O1 = (bf16_t*)(p.ws + OFF_VT); E.ld1 = LDT; }
    else { S.A0 = wt; S.B0 = h; S.nM0 = 16; S.nN0 = ntok / 256; S.A1 = wt; S.B1 = h; S.nM1 = 0; S.nN1 = 0;
        E.O0 = (bf16_t*)(p.ws + OFF_QKVZ); E.ld0 = LDT; E.O1 = E.O0; E.ld1 = LDT; }
    gemm_phase<EpiStore>(TID, (LAS unsigned char*)smem, S, E);
}
__device__ __forceinline__ void phase_g2(int TID, int BID, const P& p, int layer, int ntok, unsigned char* smem) {
    GSched S; S.G = gridDim.x; S.c = BID;
    S.A0 = (const char*)(p.ws + OFF_HOG); S.B0 = (const char*)(p.ws + OFF_WTOUT); S.nM0 = ntok / 256; S.nN0 = 4; S.A1 = S.A0; S.B1 = S.B0; S.nM1 = 0; S.nN1 = 0;
    EpiStore E; E.O0 = (bf16_t*)(p.ws + OFF_Y); E.ld0 = DM; E.O1 = E.O0; E.ld1 = DM;
    gemm_phase<EpiStore>(TID, (LAS unsigned char*)smem, S, E);
}
__device__ __forceinline__ void run_phase(int TID, int BID, const P& p, int ph, unsigned char* smem) {
    if (ph == 0) {
#if DEBUG_CHECK & 1
        if (BID == 0) dbg_fft_test(TID, p, smem);
#endif
        phase_ada(TID, BID, p, smem); filter_mlp(TID, BID, p, smem); return; }
    if (ph == NPHASE - 1) { lnmod_rows(TID, BID, p, 4, NLAT);
#if DEBUG_CHECK
        __syncthreads(); if (BID == 0 && TID == 0) { p.out[0] = 1000.0f * fmaxf(__uint_as_float(*(volatile unsigned*)(p.ws + WS_END)), __uint_as_float(*(volatile unsigned*)(p.ws + WS_END + 4))); }
#endif
        return; }
    const int q = ph - 1, lp = q / 10, r = q % 10;
    if (r < 4) { const int layer = 2 * lp;
        if (r == 0) { lnmod_rows(TID, BID, p, layer, NTOK); wconv_tiles(TID, BID, (int)gridDim.x, 0, 1280, p, layer, true, smem); }
        else if (r == 1) phase_g1(TID, BID, p, layer, true, NTOK, smem);
        else if (r == 2) phase_att(TID, BID, p, lp, smem);
        else phase_g2(TID, BID, p, layer, NTOK, smem);
    } else { const int layer = 2 * lp + 1, r2 = r - 4; const bool last = layer == 3; const int ntok = last ? NLAT : NTOK;
        if (r2 == 0) { lnmod_rows(TID, BID, p, layer, ntok); wconv_tiles(TID, BID, (int)gridDim.x, 0, 1280, p, layer, false, smem); filter_taps(TID, BID, (int)gridDim.x, p, lp, !last, smem); }
        else if (r2 == 1) phase_f2(TID, BID, p, !last, smem);
        else if (r2 == 2) phase_g1(TID, BID, p, layer, false, ntok, smem);
        else if (r2 == 3) phase_conv(TID, BID, p, lp, !last, smem);
        else if (r2 == 4) phase_transpose(TID, BID, p, ntok, smem);
        else phase_g2(TID, BID, p, layer, ntok, smem);
    }
}

#define XB_TMO      128
#define XB_XCNT(j)  (256  + 64 * (j))
#define XB_XSUB(j)  (1280 + 64 * (j))
#define XB_XGEN(j)  (2304 + 64 * (j))
#define XB_TOP      3328
#define XB_TOPGEN   3392
#define XCD_BAR_WORDS 3456
#define XB_SPIN_CAP (1u << 18)
__device__ __forceinline__ unsigned xb_ld(unsigned* p)              { return __hip_atomic_load(p, __ATOMIC_RELAXED, __HIP_MEMORY_SCOPE_AGENT); }
__device__ __forceinline__ unsigned xb_add(unsigned* p, unsigned v) { return __hip_atomic_fetch_add(p, v, __ATOMIC_RELAXED, __HIP_MEMORY_SCOPE_AGENT); }
__device__ __forceinline__ unsigned xb_xcc_id() { return (unsigned)__builtin_amdgcn_s_getreg((3 << 11) | 20) & 0xFu; }
#define XB_SPIN(cond, bar) do { unsigned _sp = 0; while (cond) { __builtin_amdgcn_s_sleep(1); \
    if ((++_sp & 255u) == 0u) { if (xb_ld(&(bar)[XB_TMO])) break; if (_sp > XB_SPIN_CAP) { atomicAdd(&(bar)[XB_TMO], 1u); break; } } } } while (0)
struct XcdBarrier { unsigned* bar; unsigned x; volatile LAS unsigned* st; };
__device__ __forceinline__ XcdBarrier xcd_barrier_post(unsigned* bar, volatile LAS unsigned* st) {
    XcdBarrier b; b.bar = bar; b.x = xb_xcc_id(); b.st = st;
    if (threadIdx.x == 0) (void)xb_add(&bar[XB_XCNT(b.x)], 1u);
    return b;
}
__device__ __forceinline__ void xcd_barrier_complete(unsigned* bar, unsigned x, unsigned& nloc, unsigned& nx) {
    const unsigned G = gridDim.x * gridDim.y * gridDim.z;
    unsigned sum, cnt, mine, sp = 0u;
    for (;;) {
        sum = 0u; cnt = 0u; mine = 0u;
#pragma unroll
        for (unsigned j = 0; j < 16; ++j) { const unsigned c = xb_ld(&bar[XB_XCNT(j)]); sum += c; cnt += (c > 0u) ? 1u : 0u; mine = (j == x) ? c : mine; }
        if (sum == G) break;
        __builtin_amdgcn_s_sleep(1);
        if ((++sp & 255u) == 0u) { if (xb_ld(&bar[XB_TMO])) break; if (sp > XB_SPIN_CAP) { atomicAdd(&bar[XB_TMO], 1u); break; } }
    }
    nloc = mine > 0u ? mine : 1u; nx = cnt > 0u ? cnt : 1u;
}
__device__ __forceinline__ void xcd_barrier(const XcdBarrier& b) {
    asm volatile("s_waitcnt vmcnt(0)" ::: "memory");
    __syncthreads();
    if (threadIdx.x == 0) {
        unsigned* bar = b.bar;
        __builtin_amdgcn_s_waitcnt(0);
        unsigned nloc = b.st[0], nx = b.st[1];
        if (nloc == 0u) { xcd_barrier_complete(bar, b.x, nloc, nx); b.st[0] = nloc; b.st[1] = nx; }
        const unsigned old = xb_add(&bar[XB_XSUB(b.x)], 1u);
        const unsigned gen = old / nloc;
        if (old + 1u == (gen + 1u) * nloc) {
            __builtin_amdgcn_fence(__ATOMIC_RELEASE, "agent");
            asm volatile("s_waitcnt vmcnt(0)" ::: "memory");
            const unsigned og = xb_add(&bar[XB_TOP], 1u);
            const unsigned tg = og / nx;
            if (og + 1u == (tg + 1u) * nx) xb_add(&bar[XB_TOPGEN], 1u);
            else XB_SPIN(xb_ld(&bar[XB_TOPGEN]) == tg, bar);
            __builtin_amdgcn_fence(__ATOMIC_ACQUIRE, "agent");
            xb_add(&bar[XB_XGEN(b.x)], 1u);
            asm volatile("s_waitcnt vmcnt(0)" ::: "memory");
        } else {
            XB_SPIN(xb_ld(&bar[XB_XGEN(b.x)]) == gen, bar);
            __builtin_amdgcn_fence(__ATOMIC_ACQUIRE, "agent");
            asm volatile("s_waitcnt vmcnt(0)" ::: "memory");
        }
    }
    __syncthreads();
}

__device__ __forceinline__ int phase_kind(int ph) {
    if (ph == 0) return 0; if (ph == NPHASE - 1) return 11; const int r = (ph - 1) % 10; return 1 + r;
}
__global__ void __launch_bounds__(512) fwd_mega(P p) {
    extern __shared__ __attribute__((aligned(16))) unsigned char smem[];
    cg::grid_group grid = cg::this_grid();
    volatile LAS unsigned* st = (volatile LAS unsigned*)((LAS unsigned char*)smem + 139392);
    if (threadIdx.x == 0) { st[0] = 0u; st[1] = 0u; }
    __syncthreads();
    const XcdBarrier xb = xcd_barrier_post((unsigned*)(p.ws + OFF_BAR), st);
    if (p.ph_hi > NPHASE) grid.sync();
    const int wid_s = __builtin_amdgcn_readfirstlane((int)threadIdx.x >> 6);
    for (int ph = p.ph_lo; ph < p.ph_hi; ++ph) {
        unsigned zero_s; asm volatile("s_mov_b32 %0, 0" : "=s"(zero_s));
        int TID = (wid_s << 6) | (int)__builtin_amdgcn_mbcnt_hi(~0u, __builtin_amdgcn_mbcnt_lo(~0u, zero_s)), BID = blockIdx.x;
        asm volatile("" : "+v"(TID));
        asm volatile("" : "+s"(BID));
#if PROBE_KIND >= 0
        const unsigned long long t0 = wall_clock64();
#endif
        run_phase(TID, BID, p, ph, smem);
        if (ph + 1 < p.ph_hi) xcd_barrier(xb);
#if PROBE_KIND >= 0
        if (phase_kind(ph) == PROBE_KIND && ph + 1 < p.ph_hi) { const unsigned long long t1 = wall_clock64(); while (wall_clock64() - t1 < t1 - t0) __builtin_amdgcn_s_sleep(8); }
#endif
    }
}

extern "C" void kernel_launch(void* const* d_in, const int* in_sizes, int n_in, void* d_out, int out_size, void* d_ws, size_t ws_size, hipStream_t stream) {
    static int grid_blocks = 0;
    if (grid_blocks == 0) {
        if (n_in != 22 || ws_size < WS_END + 64) { fprintf(stderr, "kernel_launch: unexpected n_in %d or ws_size %zu (< %zu)\n", n_in, ws_size, (size_t)WS_END); grid_blocks = -1; return; }
        int dev = 0, cus = 0, per_cu = 0;
        (void)hipGetDevice(&dev); (void)hipDeviceGetAttribute(&cus, hipDeviceAttributeMultiprocessorCount, dev);
        if (hipFuncSetAttribute((const void*)fwd_mega, hipFuncAttributeMaxDynamicSharedMemorySize, LDS_BYTES) != hipSuccess) { fprintf(stderr, "kernel_launch: hipFuncSetAttribute failed\n"); grid_blocks = -1; return; }
        if (hipOccupancyMaxActiveBlocksPerMultiprocessor(&per_cu, (const void*)fwd_mega, 512, LDS_BYTES) != hipSuccess || per_cu < 1) { fprintf(stderr, "kernel_launch: occupancy query failed (%d)\n", per_cu); (void)hipGetLastError(); grid_blocks = -1; return; }
        grid_blocks = cus * per_cu;
        if (grid_blocks > 256) grid_blocks = 256;
    }
    if (grid_blocks < 0) return;
    if (hipMemsetAsync((char*)d_ws + OFF_BAR, 0, (size_t)XCD_BAR_WORDS * 4, stream) != hipSuccess) { fprintf(stderr, "kernel_launch: memset of the barrier words failed\n"); return; }
#if DEBUG_CHECK
    (void)hipMemsetAsync((char*)d_ws + WS_END, 0, 64, stream);
#endif
    P p{};
    const float** f = (const float**)&p;
    for (int i = 0; i < 22; ++i) f[i] = (const float*)d_in[i];
    p.out = (float*)d_out; p.ws = (unsigned char*)d_ws;
#if SINGLE_LAUNCH
    p.ph_lo = 0; p.ph_hi = NPHASE;
    void* args[] = {&p};
    hipError_t e = hipLaunchCooperativeKernel((const void*)fwd_mega, dim3(grid_blocks), dim3(512), args, LDS_BYTES, stream);
    if (e != hipSuccess) fprintf(stderr, "cooperative launch failed: %s (grid %d)\n", hipGetErrorString(e), grid_blocks);
#else
    for (int ph = 0; ph < NPHASE; ++ph) { p.ph_lo = ph; p.ph_hi = ph + 1; hipLaunchKernelGGL(fwd_mega, dim3(grid_blocks), dim3(512), LDS_BYTES, stream, p); }
#endif
}
```
